# Optimizing an MI355X kernel written in HIP

```python
import jax, jax.numpy as jnp
from jax import lax
import numpy as np

D_MODEL = 2048
BATCH = 8
SEQ = 2048
DEPTH = 1

ATTN_HEAD_DIM = 64
N_Q_HEADS = D_MODEL // 128
N_KV_HEADS = N_Q_HEADS // 4
Q_PER_KV = N_Q_HEADS // N_KV_HEADS
WINDOW = 128
ATTN_BLOCK = WINDOW
ATTN_WIDTH = N_Q_HEADS * ATTN_HEAD_DIM
KV_WIDTH = N_KV_HEADS * ATTN_HEAD_DIM
HGRN_HEAD_DIM = 128
HGRN_HEADS = D_MODEL // 256
HGRN_WIDTH = HGRN_HEADS * HGRN_HEAD_DIM
HGRN_CHUNK = 64
N_BRANCHES = 2
IN_WIDTH = ATTN_WIDTH + 2 * KV_WIDTH + 4 * HGRN_WIDTH + N_BRANCHES * D_MODEL
N_GROUPS = 4
EXPERTS_PER_GROUP = 8
N_EXPERTS = N_GROUPS * EXPERTS_PER_GROUP
TOP_K = 2
D_EXPERT = D_MODEL // 4
MOE_BLOCK = 128
EPS = 1e-6

kernel_name = "hybrid_swa_sink_hgrn2_hmoe_block"


def rmsnorm(x, g):
    x32 = x.astype(jnp.float32)
    y = x32 * lax.rsqrt(jnp.mean(x32 * x32, axis=-1, keepdims=True) + EPS)
    return (y * g.astype(jnp.float32)).astype(x.dtype)


def sliding_window_sink_attention(q, k, v, sinks):
    B, S, _ = q.shape
    nb = S // ATTN_BLOCK
    q = q.reshape(B, nb, ATTN_BLOCK, N_KV_HEADS, Q_PER_KV, ATTN_HEAD_DIM)
    k = k.reshape(B, nb, ATTN_BLOCK, N_KV_HEADS, ATTN_HEAD_DIM)
    v = v.reshape(B, nb, ATTN_BLOCK, N_KV_HEADS, ATTN_HEAD_DIM)

    def band(t):
        prev = jnp.concatenate([jnp.zeros_like(t[:, :1]), t[:, :-1]], axis=1)
        return jnp.concatenate([prev, t], axis=2)

    kb, vb = band(k), band(v)
    scores = jnp.einsum('bnqhgd,bnkhd->bnhgqk', q, kb).astype(jnp.float32) * (ATTN_HEAD_DIM ** -0.5)
    qi = jnp.arange(ATTN_BLOCK)[:, None]
    kj = jnp.arange(2 * ATTN_BLOCK)[None, :]
    rel = ATTN_BLOCK + qi - kj
    in_window = (rel >= 0) & (rel < WINDOW)
    key_exists = (jnp.arange(nb) > 0)[:, None, None] | (kj >= ATTN_BLOCK)[None]
    mask = in_window[None] & key_exists
    scores = jnp.where(mask[None, :, None, None], scores, -jnp.inf)
    sink = sinks.astype(jnp.float32).reshape(N_KV_HEADS, Q_PER_KV)[None, None, :, :, None, None]
    sink = jnp.broadcast_to(sink, scores.shape[:-1] + (1,))
    probs = jax.nn.softmax(jnp.concatenate([scores, sink], axis=-1), axis=-1)[..., :-1]
    out = jnp.einsum('bnhgqk,bnkhd->bnqhgd', probs.astype(v.dtype), vb)
    return out.reshape(B, S, ATTN_WIDTH)


def hgrn2_recurrence(q, f_logit, i, lower_bound):
    B, S, _ = q.shape
    nc = S // HGRN_CHUNK

    def chunks(t):
        t = t.reshape(B, nc, HGRN_CHUNK, HGRN_HEADS, HGRN_HEAD_DIM)
        return t.transpose(1, 0, 3, 2, 4).astype(jnp.float32)

    lb = lower_bound.astype(jnp.float32).reshape(HGRN_HEADS, 1, HGRN_HEAD_DIM)
    f = lb + (1.0 - lb) * jax.nn.sigmoid(chunks(f_logit))
    qh = jax.nn.silu(chunks(q)) * (HGRN_HEAD_DIM ** -0.5)
    kh = 1.0 - f
    vh = chunks(i)
    gh = jnp.log(f)
    causal = jnp.tril(jnp.ones((HGRN_CHUNK, HGRN_CHUNK), dtype=bool))

    def step(state, inp):
        qc, kc, vc, gc = inp
        b = jnp.cumsum(gc, axis=-2)
        diff = b[:, :, :, None, :] - b[:, :, None, :, :]
        decay = jnp.exp(jnp.where(causal[None, None, :, :, None], diff, -jnp.inf))
        attn = jnp.einsum('bhtk,bhsk,bhtsk->bhts', qc, kc, decay)
        o = jnp.einsum('bhts,bhsv->bhtv', attn, vc) + jnp.einsum('bhtk,bhkv->bhtv', qc * jnp.exp(b), state)
        b_last = b[:, :, -1:, :]
        new_state = jnp.exp(b_last[:, :, 0, :])[..., None] * state + \
            jnp.einsum('bhsk,bhsv->bhkv', kc * jnp.exp(b_last - b), vc)
        return new_state, o

    s0 = jnp.zeros((B, HGRN_HEADS, HGRN_HEAD_DIM, HGRN_HEAD_DIM), jnp.float32)
    _, o = lax.scan(step, s0, (qh, kh, vh, gh))
    return o.transpose(1, 0, 3, 2, 4).reshape(B, S, HGRN_HEADS, HGRN_HEAD_DIM)


def hierarchical_moe(xn, w_rg, b_rg, w_re, b_re, w1, w3, w2):
    B, S, D = xn.shape
    T = B * S
    xf = xn.reshape(T, D)
    p_group = jax.nn.softmax((xf @ w_rg).astype(jnp.float32) + b_rg.astype(jnp.float32), axis=-1)
    group = jnp.argmax(p_group, axis=-1)
    p_sel_group = jnp.take_along_axis(p_group, group[:, None], axis=-1)
    e_logits = ((xf @ w_re).astype(jnp.float32) + b_re.astype(jnp.float32)).reshape(T, N_GROUPS, EXPERTS_PER_GROUP)
    e_logits = jnp.take_along_axis(e_logits, group[:, None, None], axis=1)[:, 0]
    top_p, top_i = lax.top_k(jax.nn.softmax(e_logits, axis=-1), TOP_K)
    weights = p_sel_group * top_p / jnp.sum(top_p, axis=-1, keepdims=True)
    expert = group[:, None] * EXPERTS_PER_GROUP + top_i

    n_assign = T * TOP_K
    flat_e = expert.reshape(-1)
    flat_w = weights.reshape(-1)
    flat_tok = jnp.arange(n_assign) // TOP_K
    order = jnp.argsort(flat_e, stable=True)
    sorted_e = flat_e[order]
    sorted_tok = flat_tok[order]
    counts = jnp.bincount(flat_e, length=N_EXPERTS)
    padded = ((counts + MOE_BLOCK - 1) // MOE_BLOCK) * MOE_BLOCK
    pad_end = jnp.cumsum(padded)
    pad_start = pad_end - padded
    start = jnp.cumsum(counts) - counts
    dest = pad_start[sorted_e] + (jnp.arange(n_assign) - start[sorted_e])
    n_blocks = -(-n_assign // MOE_BLOCK) + N_EXPERTS
    block_expert = jnp.clip(jnp.searchsorted(pad_end, jnp.arange(n_blocks) * MOE_BLOCK, side='right'), 0, N_EXPERTS - 1)
    rows = jnp.zeros((n_blocks * MOE_BLOCK, D), xf.dtype).at[dest].set(xf[sorted_tok])

    def expert_block(args):
        xb, e = args
        hb = jax.nn.silu(xb @ w1[e]) * (xb @ w3[e])
        return hb @ w2[e]

    y_rows = lax.map(expert_block, (rows.reshape(n_blocks, MOE_BLOCK, D), block_expert)).reshape(-1, D)
    contrib = y_rows[dest].astype(jnp.float32) * flat_w[order][:, None]
    out = jnp.zeros((T, D), jnp.float32).at[sorted_tok].add(contrib)
    return out.reshape(B, S, D).astype(xn.dtype)


def setup_inputs(seed: int = 0) -> dict:
    key = jax.random.key(seed)
    ks = jax.random.split(key, 18)
    f32 = jnp.float32
    nrm = lambda k, shape, s: jax.random.normal(k, shape, f32) * s
    return {
        "x": nrm(ks[0], (BATCH, SEQ, D_MODEL), 1.0),
        "w_in": nrm(ks[1], (DEPTH, D_MODEL, IN_WIDTH), D_MODEL ** -0.5),
        "attn_sinks": nrm(ks[2], (DEPTH, N_Q_HEADS), 1.0),
        "hgrn_lb_logits": nrm(ks[3], (DEPTH + 1, HGRN_WIDTH), 0.5),
        "hgrn_norm_g": 1.0 + nrm(ks[4], (DEPTH, HGRN_HEAD_DIM), 0.02),
        "w_br_attn": nrm(ks[5], (DEPTH, ATTN_WIDTH, D_MODEL), ATTN_WIDTH ** -0.5),
        "w_br_hgrn": nrm(ks[6], (DEPTH, HGRN_WIDTH, D_MODEL), HGRN_WIDTH ** -0.5),
        "w_out": nrm(ks[7], (DEPTH, D_MODEL, D_MODEL), D_MODEL ** -0.5),
        "mix_norm_g": 1.0 + nrm(ks[8], (DEPTH, D_MODEL), 0.02),
        "moe_norm_g": 1.0 + nrm(ks[9], (DEPTH, D_MODEL), 0.02),
        "w_router_group": nrm(ks[10], (DEPTH, D_MODEL, N_GROUPS), D_MODEL ** -0.5),
        "b_router_group": nrm(ks[11], (DEPTH, N_GROUPS), 0.01),
        "w_router_expert": nrm(ks[12], (DEPTH, D_MODEL, N_EXPERTS), D_MODEL ** -0.5),
        "b_router_expert": nrm(ks[13], (DEPTH, N_EXPERTS), 0.01),
        "w1": nrm(ks[14], (DEPTH, N_EXPERTS, D_MODEL, D_EXPERT), D_MODEL ** -0.5),
        "w3": nrm(ks[15], (DEPTH, N_EXPERTS, D_MODEL, D_EXPERT), D_MODEL ** -0.5),
        "w2": nrm(ks[16], (DEPTH, N_EXPERTS, D_EXPERT, D_MODEL), D_EXPERT ** -0.5),
        "final_norm_g": 1.0 + nrm(ks[17], (D_MODEL,), 0.02),
    }


def reference(x, w_in, attn_sinks, hgrn_lb_logits, hgrn_norm_g, w_br_attn, w_br_hgrn, w_out,
              mix_norm_g, moe_norm_g, w_router_group, b_router_group, w_router_expert,
              b_router_expert, w1, w3, w2, final_norm_g):
    B, S, _ = x.shape
    widths = [ATTN_WIDTH, KV_WIDTH, KV_WIDTH, HGRN_WIDTH, HGRN_WIDTH, HGRN_WIDTH, HGRN_WIDTH, N_BRANCHES * D_MODEL]
    splits = [int(c) for c in np.cumsum(widths)[:-1]]
    lb_table = jnp.cumsum(jax.nn.softmax(hgrn_lb_logits.astype(jnp.float32), axis=0), axis=0)
    h = x
    for l in range(DEPTH):
        xn = rmsnorm(h, mix_norm_g[l])
        proj = xn @ w_in[l]
        q_a, k_a, v_a, q_h, f_h, i_h, og_h, gate_logits = jnp.split(proj, splits, axis=-1)
        o_a = sliding_window_sink_attention(q_a, k_a, v_a, attn_sinks[l])
        o_h = hgrn2_recurrence(q_h, f_h, i_h, lb_table[l])
        o_h = rmsnorm(o_h, hgrn_norm_g[l]) * jax.nn.silu(og_h.astype(jnp.float32).reshape(B, S, HGRN_HEADS, HGRN_HEAD_DIM))
        o_h = o_h.reshape(B, S, HGRN_WIDTH).astype(h.dtype)
        gates = jax.nn.sigmoid(gate_logits.astype(jnp.float32)).reshape(B, S, N_BRANCHES, D_MODEL)
        y_a = o_a @ w_br_attn[l]
        y_h = o_h @ w_br_hgrn[l]
        merged = (gates[:, :, 0] * y_a + gates[:, :, 1] * y_h).astype(h.dtype)
        h = h + merged @ w_out[l]
        hn = rmsnorm(h, moe_norm_g[l])
        h = h + hierarchical_moe(hn, w_router_group[l], b_router_group[l], w_router_expert[l],
                                 b_router_expert[l], w1[l], w3[l], w2[l])
    return rmsnorm(h, final_norm_g)
```

```cpp
#define MK_N_LAUNCHES 1
#define MK_NAIVE_MIX 0
#include <hip/hip_runtime.h>
#include <cstdio>
#include <cstdint>
namespace pg8 {
#define PG8_LAS __attribute__((address_space(3)))
typedef unsigned short bf16_t;
typedef short bf16x8 __attribute__((ext_vector_type(8)));
typedef float f32x4 __attribute__((ext_vector_type(4)));
typedef unsigned u32x4 __attribute__((ext_vector_type(4)));
constexpr int BM = 256, BK = 64, HALF = 128, HTB = HALF * BK * 2  , STAGE_BYTES = 8 * HTB, NXCD = 8, WGM = 4;

__host__ __device__ __forceinline__ int lds_byte(int r, int c) { const int st = (r >> 4) * 2 + (c >> 5), rr = r & 15, cc = c & 31, ob = rr * 64 + cc * 2; return st * 1024 + (ob ^ (((ob >> 9) & 1) << 5)); }
__host__ __device__ __forceinline__ void stage_rc(int b, int& R, int& C) { const int st = b / 1024, sb = b % 1024, swz = sb ^ (((sb >> 9) & 1) << 5); R = (st >> 1) * 16 + swz / 64; C = (st & 1) * 32 + (swz % 64) / 2; }
__host__ __device__ __forceinline__ int perm32(int rho) { const int n = rho >> 4, i = rho & 15; return 8 * (i >> 2) + 4 * n + (i & 3); }

struct Unit { int pm, pn, pb, ui; };
struct Gemm { const bf16_t* A; const bf16_t* Bt; int M, N, K, lda, ldb; };

struct StaticOrder {
    int nM, nN, nwg, G, c, wgm;
    __host__ __device__ void init(int M, int N, int G_, int c_, int wgm_ = WGM) { nM = M / BM; nN = N / BM; nwg = nM * nN; G = G_; c = c_; wgm = wgm_; }
    __host__ __device__ bool next(int i, Unit& u) const {
        const long L = (long)i * G + c; if (L >= nwg) return false;
        int wgid = (int)L; { const int q = nwg / NXCD, r = nwg % NXCD, xcd = wgid % NXCD, off = wgid / NXCD; wgid = (xcd < r ? xcd * (q + 1) : r * (q + 1) + (xcd - r) * q) + off; }
        const int nig = wgm * nN, gid = wgid / nig, fm = gid * wgm, gsz = (nM - fm) < wgm ? (nM - fm) : wgm;
        u.pm = fm + ((wgid % nig) % gsz); u.pn = (wgid % nig) / gsz; u.pb = u.pn; u.ui = i; return true;
    }
    __device__ __forceinline__ void a_ready(const Unit&) const {}
    __device__ __forceinline__ void done(const Unit&) const {}
    __device__ __forceinline__ unsigned arow_off(const Unit&, int) const { return 0u; }
};

typedef float f32x2_t __attribute__((ext_vector_type(2))); typedef __bf16 bf16x2_t __attribute__((ext_vector_type(2)));
__device__ __forceinline__ unsigned cvt_pk_bf16(float lo, float hi) { f32x2_t v = {lo, hi}; bf16x2_t b = __builtin_convertvector(v, bf16x2_t); return __builtin_bit_cast(unsigned, b); }
__device__ __forceinline__ float bf_lo(unsigned w) { return __uint_as_float(w << 16); }
__device__ __forceinline__ float bf_hi(unsigned w) { return __uint_as_float(w & 0xffff0000u); }
template <class Epi, class Sched, bool ALIGN_EPI = false, bool GATHER = false, bool MIDHOOK = false, int EREP = 0>
__device__ __forceinline__ void gemm_phase(PG8_LAS unsigned char* lds, const Gemm g, const Sched& S, const Epi& E) {
    const int tid = threadIdx.x, wid = __builtin_amdgcn_readfirstlane(tid >> 6), lane = tid & 63, wr = wid >> 2, wc = wid & 3, fr = lane & 15, fq = lane >> 4;
    const int K = g.K, nt = K / BK, lda = g.lda, ldb = g.ldb;
    unsigned voffB[2]; int RA[2], CA[2];
#pragma unroll
    for (int i = 0; i < 2; ++i) { int R, C; stage_rc(tid * 16 + i * 8192, R, C); const int Rb = Epi::PERM ? ((R & ~31) + perm32(R & 31)) : R;
        RA[i] = R; CA[i] = C; voffB[i] = (unsigned)(Rb * ldb + C) * 2u; }
    const size_t kstep = (size_t)(BK * 2);
    const size_t hstep = (size_t)HALF * ldb * 2;
    const size_t tstep = 2 * hstep;
    const size_t tstepA = (size_t)BM * lda * 2;
    const unsigned ldsw = (unsigned)wid * 1024u;
    const int aoff = lds_byte(wr * 64 + fr, fq * 8), boff = lds_byte(wc * 32 + fr, fq * 8);
#define PG8_SA(b, h) (((b) * 2 + (h)) * HTB)
#define PG8_SB(b, h) ((4 + (b) * 2 + (h)) * HTB)
#define PG8_STAGE(bufoff, gbase, voff) do { _Pragma("unroll") for (int _i = 0; _i < 2; ++_i) \
        __builtin_amdgcn_global_load_lds((const unsigned*)((const char*)(gbase) + (voff)[_i]), (PG8_LAS unsigned*)(lds + (bufoff) + ldsw + _i * 8192), 16, 0, 0); } while (0)
#define PG8_LDA(dst, b, h) do { _Pragma("unroll") for (int m = 0; m < 4; ++m) _Pragma("unroll") for (int k = 0; k < 2; ++k) dst[m][k] = *(const PG8_LAS bf16x8*)(lds + PG8_SA(b, h) + aoff + m * 2048 + k * 1024); } while (0)
#define PG8_LDB(dst, b, h) do { _Pragma("unroll") for (int n = 0; n < 2; ++n) _Pragma("unroll") for (int k = 0; k < 2; ++k) dst[n][k] = *(const PG8_LAS bf16x8*)(lds + PG8_SB(b, h) + boff + n * 2048 + k * 1024); } while (0)
#define PG8_MMA(ai, bj, At, Bt) do { __builtin_amdgcn_s_setprio(1); _Pragma("unroll") for (int m = 0; m < 4; ++m) _Pragma("unroll") for (int n = 0; n < 2; ++n) _Pragma("unroll") for (int k = 0; k < 2; ++k) \
        acc[ai][bj][m][n] = __builtin_amdgcn_mfma_f32_16x16x32_bf16(Bt[n][k], At[m][k], acc[ai][bj][m][n], 0, 0, 0); __builtin_amdgcn_s_setprio(0); } while (0)
#define PG8_WAIT_V(n) asm volatile("s_waitcnt vmcnt(" #n ")" ::: "memory")
#define PG8_WAIT_L(n) asm volatile("s_waitcnt lgkmcnt(" #n ")" ::: "memory")
#define PG8_BAR __builtin_amdgcn_s_barrier()
#define PG8_SCHED __builtin_amdgcn_sched_barrier(0)
#define PG8_SETA(u, v, base) do { if constexpr (GATHER) { base = (const char*)g.A; \
        _Pragma("unroll") for (int h_ = 0; h_ < 2; ++h_) _Pragma("unroll") for (int i_ = 0; i_ < 2; ++i_) v[h_][i_] = S.arow_off(u, h_ * HALF + RA[i_]) + (unsigned)CA[i_] * 2u; } \
      else { base = (const char*)g.A + (size_t)(u).pm * tstepA; \
        _Pragma("unroll") for (int h_ = 0; h_ < 2; ++h_) _Pragma("unroll") for (int i_ = 0; i_ < 2; ++i_) v[h_][i_] = (unsigned)((RA[i_] + h_ * HALF) * lda + CA[i_]) * 2u; } } while (0)
    Unit cur, nxt; int ui = 0;
    if (!S.next(0, cur)) return;
    f32x4 acc[2][2][4][2];
#pragma unroll
    for (int a = 0; a < 2; ++a)
#pragma unroll
        for (int b = 0; b < 2; ++b)
#pragma unroll
            for (int m = 0; m < 4; ++m)
#pragma unroll
                for (int n = 0; n < 2; ++n) acc[a][b][m][n] = (f32x4){0.f, 0.f, 0.f, 0.f};
    bf16x8 At[4][2], B0[2][2], B1[2][2];
    const char* cA; unsigned vc[2][2], vn[2][2];
    PG8_SETA(cur, vc, cA);
    const char* cB = (const char*)g.Bt + (size_t)cur.pb * tstep;
    S.a_ready(cur);
    PG8_STAGE(PG8_SB(0, 0), cB, voffB); PG8_STAGE(PG8_SB(0, 1), cB + hstep, voffB); PG8_STAGE(PG8_SA(0, 0), cA, vc[0]); PG8_STAGE(PG8_SA(0, 1), cA, vc[1]);
    if (wr == 1) PG8_BAR;
    PG8_WAIT_V(2); PG8_BAR;
    PG8_STAGE(PG8_SB(1, 0), cB + kstep, voffB); PG8_STAGE(PG8_SA(1, 0), cA + kstep, vc[0]); PG8_STAGE(PG8_SB(1, 1), cB + hstep + kstep, voffB);
    PG8_WAIT_V(6); PG8_BAR;
    for (;;) {
        const bool has_next = S.next(ui + 1, nxt);
        const char* nA = cA; const char* nB = cB;
#pragma unroll
        for (int h_ = 0; h_ < 2; ++h_)
#pragma unroll
            for (int i_ = 0; i_ < 2; ++i_) vn[h_][i_] = vc[h_][i_];
        if (has_next) { PG8_SETA(nxt, vn, nA); nB = (const char*)g.Bt + (size_t)nxt.pb * tstep; }
#define PG8_KBODY \
            const bool last = (t == nt - 2); \
            const char* a1 = cA + (size_t)(t + 1) * kstep; \
            const char* a2 = last ? nA : cA + (size_t)(t + 2) * kstep; const char* b2 = last ? nB : cB + (size_t)(t + 2) * kstep; \
            const char* a3 = a2 + kstep; const char* b3 = b2 + kstep; \
            unsigned v2[2][2]; \
            _Pragma("unroll") \
            for (int h_ = 0; h_ < 2; ++h_) \
            _Pragma("unroll") \
                for (int i_ = 0; i_ < 2; ++i_) v2[h_][i_] = (GATHER && last) ? vn[h_][i_] : vc[h_][i_]; \
            if (last && has_next) S.a_ready(nxt); \
            PG8_LDB(B0, 0, 0); PG8_LDB(B1, 0, 1); PG8_SCHED; PG8_LDA(At, 0, 0); PG8_STAGE(PG8_SA(1, 1), a1, vc[1]); \
            PG8_WAIT_V(8); PG8_WAIT_L(0); PG8_BAR; PG8_MMA(0, 0, At, B0); PG8_MMA(0, 1, At, B1); PG8_BAR; PG8_SCHED; \
            PG8_LDA(At, 0, 1); PG8_STAGE(PG8_SB(0, 0), b2, voffB); PG8_STAGE(PG8_SB(0, 1), b2 + hstep, voffB); PG8_STAGE(PG8_SA(0, 0), a2, v2[0]); \
            PG8_WAIT_V(8); PG8_WAIT_L(0); PG8_BAR; PG8_MMA(1, 0, At, B0); PG8_MMA(1, 1, At, B1); PG8_BAR; PG8_SCHED; \
            PG8_LDB(B0, 1, 0); PG8_LDB(B1, 1, 1); PG8_SCHED; PG8_LDA(At, 1, 0); PG8_STAGE(PG8_SA(0, 1), a2, v2[1]); \
            PG8_WAIT_V(8); PG8_WAIT_L(0); PG8_BAR; PG8_MMA(0, 0, At, B0); PG8_MMA(0, 1, At, B1); PG8_BAR; PG8_SCHED; \
            PG8_LDA(At, 1, 1); PG8_STAGE(PG8_SB(1, 0), b3, voffB); PG8_STAGE(PG8_SB(1, 1), b3 + hstep, voffB); PG8_STAGE(PG8_SA(1, 0), a3, v2[0]); \
            PG8_WAIT_V(8); PG8_WAIT_L(0); PG8_BAR; PG8_MMA(1, 0, At, B0); PG8_MMA(1, 1, At, B1); PG8_BAR; PG8_SCHED;
        if constexpr (MIDHOOK) {
            for (int t = 0; t < (nt >> 1); t += 2) { PG8_KBODY }
            E.mid(acc, cur, wr, wc, fr, fq);
            for (int t = (nt >> 1); t < nt; t += 2) { PG8_KBODY }
        } else {
            for (int t = 0; t < nt; t += 2) { PG8_KBODY }
        }
#undef PG8_KBODY
        if constexpr (ALIGN_EPI) { if (wr == 0) PG8_BAR; }
        E(acc, cur, wr, wc, fr, fq);
        if constexpr (EREP != 0) { asm volatile("" ::: "memory"); E(acc, cur, wr, wc, fr, fq); }
        S.done(cur);
        if (!has_next) break;
#pragma unroll
        for (int a = 0; a < 2; ++a)
#pragma unroll
            for (int b = 0; b < 2; ++b)
#pragma unroll
                for (int m = 0; m < 4; ++m)
#pragma unroll
                    for (int n = 0; n < 2; ++n) acc[a][b][m][n] = (f32x4){0.f, 0.f, 0.f, 0.f};
        cur = nxt; cA = nA; cB = nB; ++ui;
#pragma unroll
        for (int h_ = 0; h_ < 2; ++h_)
#pragma unroll
            for (int i_ = 0; i_ < 2; ++i_) vc[h_][i_] = vn[h_][i_];
        if constexpr (ALIGN_EPI) { if (wr == 1) PG8_BAR; }
    }
    PG8_WAIT_V(0);
    if constexpr (!ALIGN_EPI) { if (wr == 0) PG8_BAR; }
    PG8_BAR;
#undef PG8_SA
#undef PG8_SB
#undef PG8_STAGE
#undef PG8_LDA
#undef PG8_LDB
#undef PG8_MMA
#undef PG8_WAIT_V
#undef PG8_WAIT_L
#undef PG8_BAR
#undef PG8_SCHED
#undef PG8_SETA
}
typedef int v4i_t __attribute__((ext_vector_type(4))); typedef int v8i_t __attribute__((ext_vector_type(8)));
template <class Epi, class Sched, bool ALIGN_EPI = false, bool GATHER = false, bool MIDHOOK = false, int EREP = 0>
__device__ __forceinline__ void gemm_phase_f8(PG8_LAS unsigned char* lds, const Gemm g, const Sched& S, const Epi& E) {
    const int tid = threadIdx.x, wid = __builtin_amdgcn_readfirstlane(tid >> 6), lane = tid & 63, wr = wid >> 2, wc = wid & 3, fr = lane & 15, fq = lane >> 4;
    const int K = g.K, nt = K / (2 * BK), lda = g.lda, ldb = g.ldb;
    unsigned voffB[2]; int RA[2], CA[2];
#pragma unroll
    for (int i = 0; i < 2; ++i) { int R, C; stage_rc(tid * 16 + i * 8192, R, C); const int Rb = Epi::PERM ? ((R & ~31) + perm32(R & 31)) : R;
        RA[i] = R; CA[i] = C; voffB[i] = (unsigned)(Rb * ldb + C * 2); }
    const size_t kstep = (size_t)(BK * 2);
    const size_t hstep = (size_t)HALF * ldb;
    const size_t tstep = 2 * hstep;
    const size_t tstepA = (size_t)BM * lda;
    const unsigned ldsw = (unsigned)wid * 1024u;
    const int aoff = lds_byte(wr * 64 + fr, fq * 16), boff = lds_byte(wc * 32 + fr, fq * 16);
#define PG8_SA(b, h) (((b) * 2 + (h)) * HTB)
#define PG8_SB(b, h) ((4 + (b) * 2 + (h)) * HTB)
#define PG8_STAGE(bufoff, gbase, voff) do { _Pragma("unroll") for (int _i = 0; _i < 2; ++_i) \
        __builtin_amdgcn_global_load_lds((const unsigned*)((const char*)(gbase) + (voff)[_i]), (PG8_LAS unsigned*)(lds + (bufoff) + ldsw + _i * 8192), 16, 0, 0); } while (0)
#define PG8_LDA(dst, b, h) do { _Pragma("unroll") for (int m = 0; m < 4; ++m) _Pragma("unroll") for (int k = 0; k < 2; ++k) { const v4i_t t_ = *(const PG8_LAS v4i_t*)(lds + PG8_SA(b, h) + aoff + m * 2048 + k * 16); dst[m][4 * k] = t_[0]; dst[m][4 * k + 1] = t_[1]; dst[m][4 * k + 2] = t_[2]; dst[m][4 * k + 3] = t_[3]; } } while (0)
#define PG8_LDB(dst, b, h) do { _Pragma("unroll") for (int n = 0; n < 2; ++n) _Pragma("unroll") for (int k = 0; k < 2; ++k) { const v4i_t t_ = *(const PG8_LAS v4i_t*)(lds + PG8_SB(b, h) + boff + n * 2048 + k * 16); dst[n][4 * k] = t_[0]; dst[n][4 * k + 1] = t_[1]; dst[n][4 * k + 2] = t_[2]; dst[n][4 * k + 3] = t_[3]; } } while (0)
#define PG8_MMA(ai, bj, At, Bt) do { __builtin_amdgcn_s_setprio(1); _Pragma("unroll") for (int m = 0; m < 4; ++m) _Pragma("unroll") for (int n = 0; n < 2; ++n) \
        asm volatile("v_mfma_scale_f32_16x16x128_f8f6f4 %0, %1, %2, %0, %3, %4 op_sel_hi:[0,0,0]" : "+v"(acc[ai][bj][m][n]) : "v"(Bt[n]), "v"(At[m]), "v"(scw), "v"(sca)); __builtin_amdgcn_s_setprio(0); } while (0)
#define PG8_WAIT_V(n) asm volatile("s_waitcnt vmcnt(" #n ")" ::: "memory")
#define PG8_WAIT_L(n) asm volatile("s_waitcnt lgkmcnt(" #n ")" ::: "memory")
#define PG8_BAR __builtin_amdgcn_s_barrier()
#define PG8_SCHED __builtin_amdgcn_sched_barrier(0)
#define PG8_SETA(u, v, base) do { if constexpr (GATHER) { base = (const char*)g.A; \
        _Pragma("unroll") for (int h_ = 0; h_ < 2; ++h_) _Pragma("unroll") for (int i_ = 0; i_ < 2; ++i_) v[h_][i_] = S.arow_off(u, h_ * HALF + RA[i_]) + (unsigned)CA[i_] * 2u; } \
      else { base = (const char*)g.A + (size_t)(u).pm * tstepA; \
        _Pragma("unroll") for (int h_ = 0; h_ < 2; ++h_) _Pragma("unroll") for (int i_ = 0; i_ < 2; ++i_) v[h_][i_] = (unsigned)((RA[i_] + h_ * HALF) * lda + CA[i_] * 2); } } while (0)
    Unit cur, nxt; int ui = 0;
    if (!S.next(0, cur)) return;
    f32x4 acc[2][2][4][2];
#pragma unroll
    for (int a = 0; a < 2; ++a)
#pragma unroll
        for (int b = 0; b < 2; ++b)
#pragma unroll
            for (int m = 0; m < 4; ++m)
#pragma unroll
                for (int n = 0; n < 2; ++n) acc[a][b][m][n] = (f32x4){0.f, 0.f, 0.f, 0.f};
    v8i_t At[4], B0[2], B1[2];
    int scw = g.M, sca = g.N;
    asm volatile("" : "+v"(scw), "+v"(sca));
    const char* cA; unsigned vc[2][2], vn[2][2];
    PG8_SETA(cur, vc, cA);
    const char* cB = (const char*)g.Bt + (size_t)cur.pb * tstep;
    S.a_ready(cur);
    PG8_STAGE(PG8_SB(0, 0), cB, voffB); PG8_STAGE(PG8_SB(0, 1), cB + hstep, voffB); PG8_STAGE(PG8_SA(0, 0), cA, vc[0]); PG8_STAGE(PG8_SA(0, 1), cA, vc[1]);
    if (wr == 1) PG8_BAR;
    PG8_WAIT_V(2); PG8_BAR;
    PG8_STAGE(PG8_SB(1, 0), cB + kstep, voffB); PG8_STAGE(PG8_SA(1, 0), cA + kstep, vc[0]); PG8_STAGE(PG8_SB(1, 1), cB + hstep + kstep, voffB);
    PG8_WAIT_V(6); PG8_BAR;
    for (;;) {
        const bool has_next = S.next(ui + 1, nxt);
        const char* nA = cA; const char* nB = cB;
#pragma unroll
        for (int h_ = 0; h_ < 2; ++h_)
#pragma unroll
            for (int i_ = 0; i_ < 2; ++i_) vn[h_][i_] = vc[h_][i_];
        if (has_next) { PG8_SETA(nxt, vn, nA); nB = (const char*)g.Bt + (size_t)nxt.pb * tstep; }
#define PG8_KBODY \
            const bool last = (t == nt - 2); \
            const char* a1 = cA + (size_t)(t + 1) * kstep; \
            const char* a2 = last ? nA : cA + (size_t)(t + 2) * kstep; const char* b2 = last ? nB : cB + (size_t)(t + 2) * kstep; \
            const char* a3 = a2 + kstep; const char* b3 = b2 + kstep; \
            unsigned v2[2][2]; \
            _Pragma("unroll") \
            for (int h_ = 0; h_ < 2; ++h_) \
            _Pragma("unroll") \
                for (int i_ = 0; i_ < 2; ++i_) v2[h_][i_] = (GATHER && last) ? vn[h_][i_] : vc[h_][i_]; \
            if (last && has_next) S.a_ready(nxt); \
            PG8_LDB(B0, 0, 0); PG8_LDB(B1, 0, 1); PG8_SCHED; PG8_LDA(At, 0, 0); PG8_STAGE(PG8_SA(1, 1), a1, vc[1]); \
            PG8_WAIT_V(8); PG8_WAIT_L(0); PG8_BAR; PG8_MMA(0, 0, At, B0); PG8_MMA(0, 1, At, B1); PG8_BAR; PG8_SCHED; \
            PG8_LDA(At, 0, 1); PG8_STAGE(PG8_SB(0, 0), b2, voffB); PG8_STAGE(PG8_SB(0, 1), b2 + hstep, voffB); PG8_STAGE(PG8_SA(0, 0), a2, v2[0]); \
            PG8_WAIT_V(8); PG8_WAIT_L(0); PG8_BAR; PG8_MMA(1, 0, At, B0); PG8_MMA(1, 1, At, B1); PG8_BAR; PG8_SCHED; \
            PG8_LDB(B0, 1, 0); PG8_LDB(B1, 1, 1); PG8_SCHED; PG8_LDA(At, 1, 0); PG8_STAGE(PG8_SA(0, 1), a2, v2[1]); \
            PG8_WAIT_V(8); PG8_WAIT_L(0); PG8_BAR; PG8_MMA(0, 0, At, B0); PG8_MMA(0, 1, At, B1); PG8_BAR; PG8_SCHED; \
            PG8_LDA(At, 1, 1); PG8_STAGE(PG8_SB(1, 0), b3, voffB); PG8_STAGE(PG8_SB(1, 1), b3 + hstep, voffB); PG8_STAGE(PG8_SA(1, 0), a3, v2[0]); \
            PG8_WAIT_V(8); PG8_WAIT_L(0); PG8_BAR; PG8_MMA(1, 0, At, B0); PG8_MMA(1, 1, At, B1); PG8_BAR; PG8_SCHED;
        if constexpr (MIDHOOK) {
            for (int t = 0; t < (nt >> 1); t += 2) { PG8_KBODY }
            E.mid(acc, cur, wr, wc, fr, fq);
            for (int t = (nt >> 1); t < nt; t += 2) { PG8_KBODY }
        } else {
            for (int t = 0; t < nt; t += 2) { PG8_KBODY }
        }
#undef PG8_KBODY
        asm volatile("s_nop 15\n\ts_nop 15" ::: "memory");
        if constexpr (ALIGN_EPI) { if (wr == 0) PG8_BAR; }
        E(acc, cur, wr, wc, fr, fq);
        if constexpr (EREP != 0) { asm volatile("" ::: "memory"); E(acc, cur, wr, wc, fr, fq); }
        S.done(cur);
        if (!has_next) break;
#pragma unroll
        for (int a = 0; a < 2; ++a)
#pragma unroll
            for (int b = 0; b < 2; ++b)
#pragma unroll
                for (int m = 0; m < 4; ++m)
#pragma unroll
                    for (int n = 0; n < 2; ++n) acc[a][b][m][n] = (f32x4){0.f, 0.f, 0.f, 0.f};
        cur = nxt; cA = nA; cB = nB; ++ui;
#pragma unroll
        for (int h_ = 0; h_ < 2; ++h_)
#pragma unroll
            for (int i_ = 0; i_ < 2; ++i_) vc[h_][i_] = vn[h_][i_];
        if constexpr (ALIGN_EPI) { if (wr == 1) PG8_BAR; }
    }
    PG8_WAIT_V(0);
    if constexpr (!ALIGN_EPI) { if (wr == 0) PG8_BAR; }
    PG8_BAR;
#undef PG8_SA
#undef PG8_SB
#undef PG8_STAGE
#undef PG8_LDA
#undef PG8_LDB
#undef PG8_MMA
#undef PG8_WAIT_V
#undef PG8_WAIT_L
#undef PG8_BAR
#undef PG8_SCHED
#undef PG8_SETA
}
constexpr float LOG2E = 1.4426950408889634f, LN2 = 0.6931471805599453f;
__device__ __forceinline__ float fsigmoid(float x) { return __builtin_amdgcn_rcpf(1.f + __builtin_amdgcn_exp2f(-LOG2E * x)); }
__device__ __forceinline__ u32x4 pack8(const float (&v)[8]) { u32x4 w; w.x = cvt_pk_bf16(v[0], v[1]); w.y = cvt_pk_bf16(v[2], v[3]); w.z = cvt_pk_bf16(v[4], v[5]); w.w = cvt_pk_bf16(v[6], v[7]); return w; }
__device__ __forceinline__ unsigned long long pack8_f8(const float (&v)[8]) {
    int lo = __builtin_amdgcn_cvt_pk_fp8_f32(v[0], v[1], 0, false); lo = __builtin_amdgcn_cvt_pk_fp8_f32(v[2], v[3], lo, true);
    int hi = __builtin_amdgcn_cvt_pk_fp8_f32(v[4], v[5], 0, false); hi = __builtin_amdgcn_cvt_pk_fp8_f32(v[6], v[7], hi, true);
    return (unsigned long long)(unsigned)lo | ((unsigned long long)(unsigned)hi << 32); }
__device__ __forceinline__ void unpack8_f8(const unsigned long long w, float (&v)[8]) {
    const int lo = (int)(unsigned)w, hi = (int)(unsigned)(w >> 32);
    const f32x2_t a = __builtin_amdgcn_cvt_pk_f32_fp8(lo, false), b = __builtin_amdgcn_cvt_pk_f32_fp8(lo, true), c = __builtin_amdgcn_cvt_pk_f32_fp8(hi, false), d = __builtin_amdgcn_cvt_pk_f32_fp8(hi, true);
    v[0] = a[0]; v[1] = a[1]; v[2] = b[0]; v[3] = b[1]; v[4] = c[0]; v[5] = c[1]; v[6] = d[0]; v[7] = d[1]; }
__device__ __forceinline__ void unpack8(const u32x4 w, float (&v)[8]) { v[0] = bf_lo(w.x); v[1] = bf_hi(w.x); v[2] = bf_lo(w.y); v[3] = bf_hi(w.y); v[4] = bf_lo(w.z); v[5] = bf_hi(w.z); v[6] = bf_lo(w.w); v[7] = bf_hi(w.w); }
__device__ __forceinline__ unsigned long long pack8_u8(const float (&v)[8]) {
    unsigned b[8];
#pragma unroll
    for (int j = 0; j < 8; ++j) b[j] = __float_as_uint(v[j] * 255.f + 8388608.f) & 0xffu;
    const unsigned lo = b[0] | (b[1] << 8) | (b[2] << 16) | (b[3] << 24), hi = b[4] | (b[5] << 8) | (b[6] << 16) | (b[7] << 24);
    return (unsigned long long)lo | ((unsigned long long)hi << 32); }
__device__ __forceinline__ void unpack8_u8(const unsigned long long w, float (&v)[8]) {
    const unsigned lo = (unsigned)w, hi = (unsigned)(w >> 32);
    v[0] = (float)(lo & 0xffu); v[1] = (float)((lo >> 8) & 0xffu); v[2] = (float)((lo >> 16) & 0xffu); v[3] = (float)(lo >> 24);
    v[4] = (float)(hi & 0xffu); v[5] = (float)((hi >> 8) & 0xffu); v[6] = (float)((hi >> 16) & 0xffu); v[7] = (float)(hi >> 24);
#pragma unroll
    for (int j = 0; j < 8; ++j) v[j] *= (1.f / 255.f); }
#define PG8_ACC8(v, ai, bj, m) do { const f32x4 _a = acc[ai][bj][m][0], _b = acc[ai][bj][m][1]; v[0] = _a[0]; v[1] = _a[1]; v[2] = _a[2]; v[3] = _a[3]; v[4] = _b[0]; v[5] = _b[1]; v[6] = _b[2]; v[7] = _b[3]; } while (0)

template <int MODE> __device__ __forceinline__ void proj_store(const f32x4 (&acc)[2][2][4][2], bf16_t* base, int ldc, int row0, int col0, const float* lb) {
    float lbv[2][8];
    if (MODE == 3) {
#pragma unroll
        for (int bj = 0; bj < 2; ++bj)
#pragma unroll
            for (int j = 0; j < 8; ++j) lbv[bj][j] = lb[col0 + bj * HALF + j];
    }
#pragma unroll
    for (int ai = 0; ai < 2; ++ai)
#pragma unroll
        for (int m = 0; m < 4; ++m) { bf16_t* rowp = base + (size_t)(row0 + ai * HALF + m * 16) * ldc + col0;
#pragma unroll
            for (int bj = 0; bj < 2; ++bj) { float v[8]; PG8_ACC8(v, ai, bj, m);
#pragma unroll
                for (int j = 0; j < 8; ++j) {
                    if (MODE == 0) v[j] = v[j] * (0.125f * LOG2E);
                    if (MODE == 2) v[j] = v[j] * fsigmoid(v[j]) * 0.08838834764831845f;
                    if (MODE == 3) { const float l = lbv[bj][j]; v[j] = __builtin_amdgcn_logf(l + (1.f - l) * fsigmoid(v[j])) * LN2; }
                    if (MODE == 4) v[j] = v[j] * fsigmoid(v[j]);
                    if (MODE == 5) v[j] = fsigmoid(v[j]);
                }
                if (MODE == 5) *(unsigned long long*)((unsigned char*)base + (size_t)(row0 + ai * HALF + m * 16) * ldc + col0 + bj * HALF) = pack8_u8(v);
                else *(u32x4*)(rowp + bj * HALF) = pack8(v); } }
}
struct EpiProj {
    static constexpr bool PERM = true;
    bf16_t *QA, *KA, *VA, *QH, *LF, *IH, *SOG, *GATE; const float* lb; int pn_off;
    __device__ __forceinline__ void operator()(const f32x4 (&acc)[2][2][4][2], const Unit& u, int wr, int wc, int fr, int fq) const {
        const int pn = u.pn + pn_off, row0 = u.pm * BM + wr * 64 + fr, cw = wc * 32 + 8 * fq;
        if (pn < 4)        proj_store<0>(acc, QA, 1024, row0, pn * 256 + cw, lb);
        else if (pn == 4)  proj_store<1>(acc, KA, 256, row0, cw, lb);
        else if (pn == 5)  proj_store<1>(acc, VA, 256, row0, cw, lb);
        else if (pn < 10)  proj_store<2>(acc, QH, 1024, row0, (pn - 6) * 256 + cw, lb);
        else if (pn < 14)  proj_store<3>(acc, LF, 1024, row0, (pn - 10) * 256 + cw, lb);
        else if (pn < 18)  proj_store<1>(acc, IH, 1024, row0, (pn - 14) * 256 + cw, lb);
        else if (pn < 22)  proj_store<4>(acc, SOG, 1024, row0, (pn - 18) * 256 + cw, lb);
        else               proj_store<5>(acc, GATE, 4096, row0, (pn - 22) * 256 + cw, lb);
    }
};
struct EpiGateMid {
    static constexpr bool PERM = true;
    bf16_t* MRG; const bf16_t* GATE;
    __device__ __forceinline__ void mid(f32x4 (&acc)[2][2][4][2], const Unit& u, int wr, int wc, int fr, int fq) const {
        int row0 = u.pm * BM + wr * 64 + fr, col0 = u.pn * BM + wc * 32 + 8 * fq;
        asm volatile("" : "+v"(row0), "+v"(col0));
#pragma unroll
        for (int ai = 0; ai < 2; ++ai)
#pragma unroll
            for (int m = 0; m < 4; ++m) { const bf16_t* gp = GATE + (size_t)(row0 + ai * HALF + m * 16) * 4096 + col0;
#pragma unroll
                for (int bj = 0; bj < 2; ++bj) { float g0[8], g1[8]; unpack8(*(const u32x4*)(gp + bj * HALF), g0); unpack8(*(const u32x4*)(gp + 2048 + bj * HALF), g1);
#pragma unroll
                    for (int j = 0; j < 4; ++j) { acc[ai][bj][m][0][j] *= g0[j] * __builtin_amdgcn_rcpf(g1[j]); acc[ai][bj][m][1][j] *= g0[4 + j] * __builtin_amdgcn_rcpf(g1[4 + j]); } }
                asm volatile("" ::: "memory"); }
    }
    __device__ __forceinline__ void operator()(const f32x4 (&acc)[2][2][4][2], const Unit& u, int wr, int wc, int fr, int fq) const {
        int row0 = u.pm * BM + wr * 64 + fr, col0 = u.pn * BM + wc * 32 + 8 * fq;
        asm volatile("" : "+v"(row0), "+v"(col0));
#pragma unroll
        for (int ai = 0; ai < 2; ++ai)
#pragma unroll
            for (int m = 0; m < 4; ++m) { const size_t r = (size_t)(row0 + ai * HALF + m * 16);
#pragma unroll
                for (int bj = 0; bj < 2; ++bj) { float v[8], gg[8]; PG8_ACC8(v, ai, bj, m); unpack8(*(const u32x4*)(GATE + r * 4096 + 2048 + col0 + bj * HALF), gg);
#pragma unroll
                    for (int j = 0; j < 8; ++j) v[j] *= gg[j];
                    *(u32x4*)(MRG + r * 2048 + col0 + bj * HALF) = pack8(v); } }
    }
};
template <bool FIRST> struct EpiGate {
    static constexpr bool PERM = true;
    bf16_t* MRG; const unsigned char* GATE; unsigned char* M8;
    __device__ __forceinline__ void operator()(const f32x4 (&acc)[2][2][4][2], const Unit& u, int wr, int wc, int fr, int fq) const {
        const int row0 = u.pm * BM + wr * 64 + fr, col0 = u.pn * BM + wc * 32 + 8 * fq;
#pragma unroll
        for (int ai = 0; ai < 2; ++ai) {
            unsigned long long gw[4][2]; u32x4 pw[4][2];
#pragma unroll
            for (int m = 0; m < 4; ++m)
#pragma unroll
                for (int bj = 0; bj < 2; ++bj) { const size_t r = (size_t)(row0 + ai * HALF + m * 16);
                    gw[m][bj] = *(const unsigned long long*)(GATE + r * 4096 + (FIRST ? 0 : 2048) + col0 + bj * HALF);
                    if (!FIRST) pw[m][bj] = *(const u32x4*)(MRG + r * 2048 + col0 + bj * HALF); }
#pragma unroll
            for (int m = 0; m < 4; ++m)
#pragma unroll
                for (int bj = 0; bj < 2; ++bj) { const size_t r = (size_t)(row0 + ai * HALF + m * 16);
                    float v[8], gg[8]; PG8_ACC8(v, ai, bj, m); unpack8_u8(gw[m][bj], gg);
                    if (FIRST) {
#pragma unroll
                        for (int j = 0; j < 8; ++j) v[j] *= gg[j];
                    } else { float pv[8]; unpack8(pw[m][bj], pv);
#pragma unroll
                        for (int j = 0; j < 8; ++j) v[j] = pv[j] + v[j] * gg[j]; }
                    if (!FIRST && M8) {
#pragma unroll
                        for (int j = 0; j < 8; ++j) v[j] *= 8.f;
                        *(unsigned long long*)(M8 + r * 2048 + col0 + bj * HALF) = pack8_f8(v); }
                    else *(u32x4*)(MRG + r * 2048 + col0 + bj * HALF) = pack8(v); }
        }
    }
};
struct EpiRes {
    static constexpr bool PERM = true;
    const float* X; bf16_t* HN; unsigned char* HN8;
    __device__ __forceinline__ void operator()(const f32x4 (&acc)[2][2][4][2], const Unit& u, int wr, int wc, int fr, int fq) const {
        const int row0 = u.pm * BM + wr * 64 + fr, col0 = u.pn * BM + wc * 32 + 8 * fq;
#pragma unroll
        for (int ai = 0; ai < 2; ++ai) {
            f32x4 xv[4][2][2];
#pragma unroll
            for (int m = 0; m < 4; ++m)
#pragma unroll
                for (int bj = 0; bj < 2; ++bj) { const size_t off = (size_t)(row0 + ai * HALF + m * 16) * 2048 + col0 + bj * HALF;
                    xv[m][bj][0] = *(const f32x4*)(X + off); xv[m][bj][1] = *(const f32x4*)(X + off + 4); }
#pragma unroll
            for (int m = 0; m < 4; ++m)
#pragma unroll
                for (int bj = 0; bj < 2; ++bj) { const size_t off = (size_t)(row0 + ai * HALF + m * 16) * 2048 + col0 + bj * HALF;
                    const f32x4 h0 = xv[m][bj][0] + acc[ai][bj][m][0], h1 = xv[m][bj][1] + acc[ai][bj][m][1];
                    u32x4 w; w.x = cvt_pk_bf16(h0[0], h0[1]); w.y = cvt_pk_bf16(h0[2], h0[3]); w.z = cvt_pk_bf16(h1[0], h1[1]); w.w = cvt_pk_bf16(h1[2], h1[3]);
                    *(u32x4*)(HN + off) = w;
                    const float hv[8] = {h0[0], h0[1], h0[2], h0[3], h1[0], h1[1], h1[2], h1[3]}; *(unsigned long long*)(HN8 + off) = pack8_f8(hv); }
        }
    }
};
struct EpiSwiGLU {
    static constexpr bool PERM = true;
    unsigned char* HB; const PG8_LAS float* rst;
    __device__ __forceinline__ void operator()(const f32x4 (&acc)[2][2][4][2], const Unit& u, int wr, int wc, int fr, int fq) const {
        const int rl0 = wr * 64 + fr, col0 = u.pn * 128 + wc * 32 + 8 * fq;
#pragma unroll
        for (int ai = 0; ai < 2; ++ai)
#pragma unroll
            for (int m = 0; m < 4; ++m) { const int rl = rl0 + ai * HALF + m * 16; const float rs = rst[u.ui * 256 + rl];
                float a[8], b[8]; PG8_ACC8(a, ai, 0, m); PG8_ACC8(b, ai, 1, m);
#pragma unroll
                for (int j = 0; j < 8; ++j) { const float x = a[j] * rs; a[j] = x * fsigmoid(x) * (b[j] * rs); }
                *(unsigned long long*)(HB + (size_t)(u.pm * BM + rl) * 512 + col0) = pack8_f8(a); }
    }
};
struct EpiY {
    static constexpr bool PERM = true;
    unsigned char* Y;
    __device__ __forceinline__ void operator()(const f32x4 (&acc)[2][2][4][2], const Unit& u, int wr, int wc, int fr, int fq) const {
        const int row0 = u.pm * BM + wr * 64 + fr, col0 = u.pn * BM + wc * 32 + 8 * fq;
#pragma unroll
        for (int ai = 0; ai < 2; ++ai)
#pragma unroll
            for (int m = 0; m < 4; ++m) { unsigned char* rowp = Y + (size_t)(row0 + ai * HALF + m * 16) * 2048 + col0;
#pragma unroll
                for (int bj = 0; bj < 2; ++bj) { float v[8]; PG8_ACC8(v, ai, bj, m);
#pragma unroll
                    for (int j = 0; j < 8; ++j) v[j] *= 16.f;
                    *(unsigned long long*)(rowp + bj * HALF) = pack8_f8(v); } }
    }
};
struct MoeOrder {
    int nN, total, G, c, K2; const PG8_LAS int* tile_e; const PG8_LAS int* tokt;
    __device__ __forceinline__ bool next(int i, Unit& u) const {
        const int L = i * G + c; if (L >= total) return false;
        const int mt = L / nN, pn = L - mt * nN; u.pm = mt; u.pn = pn; u.pb = tile_e[mt] * nN + pn; u.ui = i; return true;
    }
    __device__ __forceinline__ void a_ready(const Unit&) const {}
    __device__ __forceinline__ void done(const Unit&) const {}
    __device__ __forceinline__ unsigned arow_off(const Unit& u, int r) const { return (unsigned)tokt[u.ui * 256 + r] * (unsigned)K2; }
};
}
constexpr int NWAVES = 8;
#ifndef MK_N_LAUNCHES
#define MK_N_LAUNCHES 1
#endif
#ifndef MK_NAIVE_MIX
#define MK_NAIVE_MIX 0
#endif
constexpr int N_PHASES = 9;
constexpr bool ONE_LAUNCH = (MK_N_LAUNCHES == 1);

constexpr int TOK = 16384, DM = 2048, SEQ = 2048, NBATCH = 8, INW = 9728;
constexpr int NEXP = 32, DEXP = 512;
constexpr float EPS = 1e-6f;
constexpr size_t MiB = 1u << 20;
constexpr size_t WS_CTL = 0, CTL_ZERO_BYTES = 64 * 1024;
constexpr size_t WS_LB = 1 * MiB;
constexpr size_t WS_RSTD = 1 * MiB + 64 * 1024;
constexpr size_t WS_TOKE = 1 * MiB + 128 * 1024;
constexpr size_t WS_TOKP = 1 * MiB + 256 * 1024;
constexpr size_t WS_TOKW = 1 * MiB + 384 * 1024;
constexpr size_t WS_WR2 = 1 * MiB + 512 * 1024;
constexpr size_t WS_TOKL = 3 * MiB;
constexpr size_t WS_WIN = 5 * MiB, WS_WBA = 43 * MiB, WS_WBH = 47 * MiB, WS_WOUT = 51 * MiB, WS_W13 = 59 * MiB, WS_W2 = 187 * MiB;
constexpr size_t WS_QA = 251 * MiB, WS_KA = 283 * MiB, WS_VA = 291 * MiB, WS_QH = 299 * MiB, WS_LF = 331 * MiB, WS_IH = 363 * MiB, WS_SOG = 395 * MiB, WS_GATE = 427 * MiB;
constexpr size_t WS_MRG = 555 * MiB;
constexpr size_t WS_XN8 = 555 * MiB, WS_WG8 = 587 * MiB;
constexpr size_t WS_HN = 291 * MiB;
constexpr size_t WS_HB = 251 * MiB;
constexpr size_t WS_Y = 355 * MiB;
constexpr size_t WS_END = 619 * MiB;
constexpr int MAX_SLOTS = 40960;
#ifndef LDP1
#define LDP1 2048
#endif
constexpr size_t WS_MRG8 = 363 * MiB;
#ifndef P0_ALLW
#define P0_ALLW 0
#endif
#ifndef P4_F8
#define P4_F8 0
#endif
constexpr size_t HN8_OFF = 64 * MiB;
constexpr int CW_TMO = 0, CW_CODE = 1;
constexpr int CW_BAR = 4096;
constexpr int CW_WQ = 8192;
constexpr int CW_ECNT = 8192 + 64;
constexpr int CW_GCEN = 14336, CW_GARR = CW_GCEN + 128, CW_GTOP = CW_GARR + 256;
static_assert((CW_ECNT + 64 * 80) <= CW_GCEN && (CW_GTOP + 64 * 16) * 4 <= (int)CTL_ZERO_BYTES, "CTL words inside the memset region");
constexpr int RING_OFF = 0, RING_BYTES = 131072;
constexpr int XOFF = RING_BYTES;
constexpr int X_TILE_E = XOFF, X_PSTART = XOFF + 1024, X_ECNT = XOFF + 1280, X_NTILE = XOFF + 1536, X_TOKT = XOFF + 2048, X_RST = XOFF + 8192, MISC_OFF = XOFF + 15360;
constexpr int MAXU = 6;
constexpr int LDS_BYTES = 147456;
static_assert(X_TOKT + MAXU * 1024 <= X_RST && X_RST + MAXU * 1024 <= MISC_OFF && MISC_OFF + 64 <= LDS_BYTES, "LDS map");

#define GAS __attribute__((address_space(1)))
#define LAS __attribute__((address_space(3)))
typedef unsigned short bf16;
typedef unsigned v4u __attribute__((ext_vector_type(4)));
typedef float f32x4 __attribute__((ext_vector_type(4)));
typedef float f32x16 __attribute__((ext_vector_type(16)));
typedef short bf16x8 __attribute__((ext_vector_type(8)));
typedef short bf16x4 __attribute__((ext_vector_type(4)));
typedef GAS unsigned gu32;
typedef GAS unsigned long long gu64;
#define RLX_AGENT __ATOMIC_RELAXED, __HIP_MEMORY_SCOPE_AGENT
#define LDS_WAIT() asm volatile("s_waitcnt lgkmcnt(0)" ::: "memory")
#define VM_WAIT() asm volatile("s_waitcnt vmcnt(0)" ::: "memory")
__device__ __forceinline__ unsigned f2bf(float f) { unsigned u = __builtin_bit_cast(unsigned, f); return (u + 0x7fffu + ((u >> 16) & 1u)) >> 16; }
__device__ __forceinline__ unsigned pk2(float lo, float hi) { return f2bf(lo) | (f2bf(hi) << 16); }

#define XB_TMO      128
#define XB_XCNT(j)  (256  + 64 * (j))
#define XB_XSUB(j)  (1280 + 64 * (j))
#define XB_XGEN(j)  (2304 + 64 * (j))
#define XB_TOP      3328
#define XB_TOPGEN   3392
#define XCD_BAR_WORDS 3456
#define XB_SPIN_CAP (1u << 18)

__device__ __forceinline__ unsigned xb_ld(unsigned* p)              { return __hip_atomic_load(p, __ATOMIC_RELAXED, __HIP_MEMORY_SCOPE_AGENT); }
__device__ __forceinline__ unsigned xb_add(unsigned* p, unsigned v) { return __hip_atomic_fetch_add(p, v, __ATOMIC_RELAXED, __HIP_MEMORY_SCOPE_AGENT); }
__device__ __forceinline__ unsigned xb_xcc_id() { return (unsigned)__builtin_amdgcn_s_getreg((3 << 11) | 20) & 0xFu; }
#define XB_SPIN(cond, bar) do { unsigned _sp = 0; while (cond) { __builtin_amdgcn_s_sleep(1); \
    if ((++_sp & 255u) == 0u) { if (xb_ld(&(bar)[XB_TMO])) break; if (_sp > XB_SPIN_CAP) { atomicAdd(&(bar)[XB_TMO], 1u); break; } } } } while (0)

struct XcdBarrier {
    unsigned* bar; unsigned x;
    volatile LAS unsigned* st;
};

__device__ __forceinline__ XcdBarrier xcd_barrier_post(unsigned* bar, volatile LAS unsigned* st) {
    XcdBarrier b; b.bar = bar; b.x = xb_xcc_id(); b.st = st;
    if (threadIdx.x == 0) (void)xb_add(&bar[XB_XCNT(b.x)], 1u);
    return b;
}
__device__ __forceinline__ void xcd_barrier_complete(unsigned* bar, unsigned x, unsigned& nloc, unsigned& nx) {
    const unsigned G = gridDim.x * gridDim.y * gridDim.z;
    unsigned sum, cnt, mine, sp = 0u;
    for (;;) {
        sum = 0u; cnt = 0u; mine = 0u;
#pragma unroll
        for (unsigned j = 0; j < 16; ++j) { const unsigned c = xb_ld(&bar[XB_XCNT(j)]); sum += c; cnt += (c > 0u) ? 1u : 0u; mine = (j == x) ? c : mine; }
        if (sum == G) break;
        __builtin_amdgcn_s_sleep(1);
        if ((++sp & 255u) == 0u) { if (xb_ld(&bar[XB_TMO])) break; if (sp > XB_SPIN_CAP) { atomicAdd(&bar[XB_TMO], 1u); break; } }
    }
    nloc = mine > 0u ? mine : 1u; nx = cnt > 0u ? cnt : 1u;
}

__device__ __forceinline__ void xcd_barrier(const XcdBarrier& b) {
    asm volatile("s_waitcnt vmcnt(0)" ::: "memory");
    __syncthreads();
    if (threadIdx.x == 0) {
        unsigned* bar = b.bar;
        __builtin_amdgcn_s_waitcnt(0);
        unsigned nloc = b.st[0], nx = b.st[1];
        if (nloc == 0u) { xcd_barrier_complete(bar, b.x, nloc, nx); b.st[0] = nloc; b.st[1] = nx; }
        const unsigned old = xb_add(&bar[XB_XSUB(b.x)], 1u);
        const unsigned gen = old / nloc;
        if (old + 1u == (gen + 1u) * nloc) {
            __builtin_amdgcn_fence(__ATOMIC_RELEASE, "agent");
            asm volatile("s_waitcnt vmcnt(0)" ::: "memory");
            const unsigned og = xb_add(&bar[XB_TOP], 1u);
            const unsigned tg = og / nx;
            if (og + 1u == (tg + 1u) * nx) xb_add(&bar[XB_TOPGEN], 1u);
            else XB_SPIN(xb_ld(&bar[XB_TOPGEN]) == tg, bar);
            __builtin_amdgcn_fence(__ATOMIC_ACQUIRE, "agent");
            xb_add(&bar[XB_XGEN(b.x)], 1u);
            asm volatile("s_waitcnt vmcnt(0)" ::: "memory");
        } else {
            XB_SPIN(xb_ld(&bar[XB_XGEN(b.x)]) == gen, bar);
            __builtin_amdgcn_fence(__ATOMIC_ACQUIRE, "agent");
            asm volatile("s_waitcnt vmcnt(0)" ::: "memory");
        }
    }
    __syncthreads();
}

struct Frame {
    LAS unsigned char* lds;
    volatile LAS unsigned* MISC;
    gu32* ctl;
    int tid, lane, wave;
    int vcu, G;
    const float *x, *w_in, *sinks, *lbl, *hg, *wba, *wbh, *wout, *g_mix, *g_moe, *w_rg, *b_rg, *w_re, *b_re, *w1, *w3, *w2, *g_fin;
    float* out;
    unsigned char* ws;
};
#define LDS_WAIT_() asm volatile("s_waitcnt lgkmcnt(0)" ::: "memory")
__device__ __forceinline__ void p0_transpose_item(const float* W, int K, int N, bf16* WT, int kb, int nb, int row_off, LAS float* scr, int lane, int ldk = 0, int koff = 0, const float* kscale = nullptr, float f8scale = 0.f) {
    if (ldk == 0) ldk = K;
    const int k0 = 64 * kb, n0 = 32 * nb;
#pragma unroll 8
    for (int i = 0; i < 32; ++i) { const int kk = 2 * i + (lane >> 5); scr[kk * 33 + (lane & 31)] = W[(size_t)(k0 + kk) * N + n0 + (lane & 31)]; }
    LDS_WAIT(); asm volatile("" ::: "memory");
    const int c = lane & 7;
    f32x4 s0 = (f32x4){1.f, 1.f, 1.f, 1.f}, s1 = s0;
    if (kscale) { s0 = *(const f32x4*)(kscale + k0 + 8 * c); s1 = *(const f32x4*)(kscale + k0 + 8 * c + 4); }
    if (f8scale != 0.f) { s0 *= f8scale; s1 *= f8scale; }
#pragma unroll
    for (int j = 0; j < 4; ++j) { const int n = (lane >> 3) + 8 * j; const LAS float* s = scr + (8 * c) * 33 + n;
        if (f8scale != 0.f) {
            int lo = __builtin_amdgcn_cvt_pk_fp8_f32(s[0 * 33] * s0.x, s[1 * 33] * s0.y, 0, false); lo = __builtin_amdgcn_cvt_pk_fp8_f32(s[2 * 33] * s0.z, s[3 * 33] * s0.w, lo, true);
            int hi = __builtin_amdgcn_cvt_pk_fp8_f32(s[4 * 33] * s1.x, s[5 * 33] * s1.y, 0, false); hi = __builtin_amdgcn_cvt_pk_fp8_f32(s[6 * 33] * s1.z, s[7 * 33] * s1.w, hi, true);
            *(GAS unsigned long long*)((unsigned char*)WT + (size_t)(row_off + n0 + n) * ldk + koff + k0 + 8 * c) = (unsigned long long)(unsigned)lo | ((unsigned long long)(unsigned)hi << 32);
            continue; }
        v4u o; o.x = pk2(s[0 * 33] * s0.x, s[1 * 33] * s0.y); o.y = pk2(s[2 * 33] * s0.z, s[3 * 33] * s0.w); o.z = pk2(s[4 * 33] * s1.x, s[5 * 33] * s1.y); o.w = pk2(s[6 * 33] * s1.z, s[7 * 33] * s1.w);
        *(GAS v4u*)(WT + (size_t)(row_off + n0 + n) * ldk + koff + k0 + 8 * c) = o; }
    LDS_WAIT(); asm volatile("" ::: "memory");
}
__device__ __forceinline__ void moe_weight_item(Frame& F, int r) {
    LAS float* scr = (LAS float*)(F.lds + RING_OFF + F.wave * 16384);
    bf16* W13T = (bf16*)(F.ws + WS_W13); bf16* W2T = (bf16*)(F.ws + WS_W2);
    constexpr int I_E = 512 * NEXP;
    if (r < 2 * I_E) {
        const int is3 = r >= I_E; if (is3) r -= I_E;
        const int e = r / 512, q = r % 512, kb = q / 16, nb = q % 16, n0 = 32 * nb;
        const int row_off = e * 1024 + 256 * (n0 >> 7) + (n0 & 127) + (is3 ? 128 : 0) - n0;
        p0_transpose_item((is3 ? F.w3 : F.w1) + (size_t)e * DM * DEXP, DM, DEXP, W13T, kb, nb, row_off, scr, F.lane, 0, 0, F.g_moe, 64.f);
    } else if (r >= 3 * I_E) {
        r -= 3 * I_E;
        bf16* WbaT = (bf16*)(F.ws + WS_WBA); bf16* WoutT = (bf16*)(F.ws + WS_WOUT);
        if (r < 1024) p0_transpose_item(F.wba, 1024, DM, WbaT, r / 64, r % 64, 0, scr, F.lane, DM, 0);
        else if (r < 2048) { r -= 1024; p0_transpose_item(F.wbh, 1024, DM, WbaT, r / 64, r % 64, 0, scr, F.lane, DM, 1024); }
        else { r -= 2048; p0_transpose_item(F.wout, DM, DM, WoutT, r / 64, r % 64, 0, scr, F.lane, 0, 0, nullptr, P4_F8 ? 64.f : 0.f); }
    } else {
        r -= 2 * I_E;
        const int e = r / 512, q = r % 512, kb = q / 64, nb = q % 64;
        p0_transpose_item(F.w2 + (size_t)e * DEXP * DM, DEXP, DM, (bf16*)((unsigned char*)W2T + (size_t)e * DM * DEXP), kb, nb, 0, scr, F.lane, 0, 0, nullptr, 32.f);
    }
}
#if !MK_NAIVE_MIX
namespace mix {
using pg8::cvt_pk_bf16; using pg8::LOG2E;
typedef unsigned u32x2 __attribute__((ext_vector_type(2)));
typedef short v4i16_t __attribute__((ext_vector_type(4)));
__device__ __forceinline__ float bf2f(bf16 h) { return __uint_as_float((unsigned)h << 16); }
__device__ __forceinline__ bf16x8 mk8(unsigned a, unsigned b, unsigned c, unsigned d) { v4u w; w.x = a; w.y = b; w.z = c; w.w = d; return __builtin_bit_cast(bf16x8, w); }
__device__ __forceinline__ bf16x4 vtr(const LAS unsigned char* p) { return __builtin_bit_cast(bf16x4, __builtin_amdgcn_ds_read_tr16_b64_v4i16((LAS v4i16_t*)p)); }
__device__ __forceinline__ int crow(int r, int h) { return (r & 3) + 8 * (r >> 2) + 4 * h; }
template <int CTRL> __device__ __forceinline__ float dpp_f(float x) { return __builtin_bit_cast(float, __builtin_amdgcn_update_dpp(0, __builtin_bit_cast(int, x), CTRL, 0xF, 0xF, true)); }
__device__ __forceinline__ float row16_sum(float x) { x += dpp_f<0xB1>(x); x += dpp_f<0x4E>(x); x += dpp_f<0x124>(x); x += dpp_f<0x128>(x); return x; }

constexpr int KP = 144;
constexpr int ATT_K = 0, ATT_V = 256 * KP, ATT_STG = 2 * 256 * KP;
static_assert(ATT_STG + 8 * 32 * KP <= RING_BYTES, "attention LDS map");
__device__ __forceinline__ void attn_unit(Frame& F, int b, int n, int hkv) {
    const bf16* QA = (const bf16*)(F.ws + WS_QA); const bf16* KA = (const bf16*)(F.ws + WS_KA); const bf16* VA = (const bf16*)(F.ws + WS_VA); bf16* OA = (bf16*)F.out;
    LAS unsigned char* Kb = F.lds + RING_OFF + ATT_K; LAS unsigned char* Vb = F.lds + RING_OFF + ATT_V;
    const int lane = F.lane, l31 = lane & 31, h = lane >> 5;
    const size_t blk0 = (size_t)b * SEQ + (size_t)n * 128;
    {
        const int j0 = (n == 0) ? 128 : 0;
        v4u kv[4], vv[4];
#pragma unroll
        for (int i = 0; i < 4; ++i) { const int c = F.tid + 512 * i, row = c >> 3, part = c & 7, rowc = row < j0 ? j0 : row;
            const size_t g = (blk0 - 128 + rowc) * 256 + hkv * 64 + part * 8; kv[i] = *(const v4u*)(KA + g); vv[i] = *(const v4u*)(VA + g); }
#pragma unroll
        for (int i = 0; i < 4; ++i) { const int c = F.tid + 512 * i, row = c >> 3, part = c & 7;
            *(LAS v4u*)(Kb + row * KP + part * 16) = kv[i]; *(LAS v4u*)(Vb + row * KP + part * 16) = vv[i]; }
    }
    __syncthreads();
    const int g = F.wave >> 1;
    const int hq = hkv * 4 + g; const float sink2 = F.sinks[hq] * LOG2E;
#pragma unroll 1
    for (int rr = 0; rr < 2; ++rr) {
        const int rblk = (F.wave & 1) * 2 + rr;
        const size_t qrow = blk0 + 32 * rblk + l31;
        bf16x8 qf[4];
#pragma unroll
        for (int s = 0; s < 4; ++s) qf[s] = *(const bf16x8*)(QA + qrow * 1024 + hq * 64 + 16 * s + 8 * h);
        f32x16 sc[5];
#pragma unroll
        for (int i = 0; i < 5; ++i) {
            const int jt = rblk + i;
            f32x16 acc;
#pragma unroll
            for (int r = 0; r < 16; ++r) acc[r] = 0.f;
            if (n > 0 || jt >= 4) {
#pragma unroll
                for (int s = 0; s < 4; ++s) { const bf16x8 a = *(const LAS bf16x8*)(Kb + (32 * jt + l31) * KP + (16 * s + 8 * h) * 2);
                    acc = __builtin_amdgcn_mfma_f32_32x32x16_bf16(a, qf[s], acc, 0, 0, 0); }
#pragma unroll
                for (int r = 0; r < 16; ++r) { const int c = crow(r, h);
                    if (i == 0) acc[r] = (c > l31) ? acc[r] : -1.0e30f;
                    if (i == 4) acc[r] = (c <= l31) ? acc[r] : -1.0e30f; }
            } else {
#pragma unroll
                for (int r = 0; r < 16; ++r) acc[r] = -1.0e30f;
            }
            sc[i] = acc;
        }
        float m = sink2;
#pragma unroll
        for (int i = 0; i < 5; ++i)
#pragma unroll
            for (int r = 0; r < 16; ++r) m = fmaxf(m, sc[i][r]);
        m = fmaxf(m, __shfl_xor(m, 32));
        float l = 0.f;
#pragma unroll
        for (int i = 0; i < 5; ++i)
#pragma unroll
            for (int r = 0; r < 16; ++r) { const float p = __builtin_amdgcn_exp2f(sc[i][r] - m); sc[i][r] = p; l += p; }
        l += __shfl_xor(l, 32);
        l += __builtin_amdgcn_exp2f(sink2 - m);
        const float inv = 1.0f / l;
        f32x16 o[2];
#pragma unroll
        for (int r = 0; r < 16; ++r) { o[0][r] = 0.f; o[1][r] = 0.f; }
        const int i16 = lane & 15, tq = i16 >> 2, tp = i16 & 3, g16 = (lane >> 4) & 1;
#pragma unroll
        for (int i = 0; i < 5; ++i) {
            const int jt = rblk + i;
            if (n > 0 || jt >= 4) {
#pragma unroll
                for (int s = 0; s < 2; ++s) {
                    const bf16x8 pa = mk8(cvt_pk_bf16(sc[i][8 * s] * inv, sc[i][8 * s + 1] * inv), cvt_pk_bf16(sc[i][8 * s + 2] * inv, sc[i][8 * s + 3] * inv),
                                          cvt_pk_bf16(sc[i][8 * s + 4] * inv, sc[i][8 * s + 5] * inv), cvt_pk_bf16(sc[i][8 * s + 6] * inv, sc[i][8 * s + 7] * inv));
#pragma unroll
                    for (int dn = 0; dn < 2; ++dn) {
                        const LAS unsigned char* vp = Vb + (32 * jt + 16 * s + 4 * h + tq) * KP + (dn * 32 + 16 * g16 + 4 * tp) * 2;
                        const bf16x4 lo = vtr(vp), hi = vtr(vp + 8 * KP);
                        const bf16x8 vb = __builtin_shufflevector(lo, hi, 0, 1, 2, 3, 4, 5, 6, 7);
                        o[dn] = __builtin_amdgcn_mfma_f32_32x32x16_bf16(pa, vb, o[dn], 0, 0, 0);
                    }
                }
            }
        }
        { LAS unsigned char* stg = F.lds + RING_OFF + ATT_STG + F.wave * (32 * KP);
#pragma unroll
          for (int dn = 0; dn < 2; ++dn)
#pragma unroll
              for (int r = 0; r < 16; ++r) *(LAS unsigned short*)(stg + crow(r, h) * KP + (dn * 32 + l31) * 2) = (unsigned short)(cvt_pk_bf16(o[dn][r], 0.f) & 0xffffu);
          asm volatile("s_waitcnt lgkmcnt(0)" ::: "memory");
          const int orow = lane >> 1, ohalf = lane & 1;
          v4u t4[4];
#pragma unroll
          for (int j = 0; j < 4; ++j) t4[j] = *(const LAS v4u*)(stg + orow * KP + ohalf * 64 + j * 16);
          bf16* op = OA + (blk0 + 32 * rblk + orow) * 2048 + hq * 64 + ohalf * 32;
#pragma unroll
          for (int j = 0; j < 4; ++j) *(v4u*)(op + 8 * j) = t4[j];
          asm volatile("s_waitcnt lgkmcnt(0)" ::: "memory"); }
    }
    __syncthreads();
}

constexpr int QP = 272, AP = 80, TILE = 32 * QP;
constexpr int HRAW = 0, HQT = 8 * TILE, HKT = HQT + TILE, HKH = HKT + TILE, HDD = HKH + 8192, HAM = HDD + 512, HSS = HAM + 32 * AP, HOT = HSS + 1024;
static_assert(HOT + TILE <= RING_BYTES, "HGRN LDS map");
#define LBAR() do { asm volatile("s_waitcnt lgkmcnt(0)" ::: "memory"); __builtin_amdgcn_s_barrier(); asm volatile("" ::: "memory"); } while (0)
constexpr int PRAW = 0, PKT = 6 * TILE, PAM = PKT + TILE, POUT = PAM + 32 * AP;
static_assert(POUT + 6 * TILE <= RING_BYTES, "HGRN prep LDS map");
__device__ __forceinline__ void hgrn_prep_unit(Frame& F, int b, int h, int cg, int dummy = 0) {
    const bf16* QHp = (const bf16*)(F.ws + WS_QH); const bf16* LFp = (const bf16*)(F.ws + WS_LF); const bf16* IHp = (const bf16*)(F.ws + WS_IH);
    bf16* QHo = dummy ? (bf16*)(F.ws + 555 * MiB) : (bf16*)(F.ws + WS_QH); bf16* LFo = dummy ? (bf16*)(F.ws + 587 * MiB) : (bf16*)(F.ws + WS_LF);
    bf16* OI = dummy ? (bf16*)(F.ws + 555 * MiB) : (bf16*)((unsigned char*)F.out + 64 * MiB); float* DD = dummy ? (float*)((unsigned char*)F.out + 98 * MiB) : (float*)((unsigned char*)F.out + 96 * MiB);
    LAS unsigned char* L = F.lds + RING_OFF;
    const int lane = F.lane, w = F.wave, fr = lane & 15, q = lane >> 4, tq = fr >> 2, tp = fr & 3;
    const int kcol = 16 * w + fr, cb = h * 128;
    const int lrow = F.tid >> 4, lpart = F.tid & 15;
    const int trc = (16 * w + 4 * tp) * 2;
    bf16x8 LA[2];
#pragma unroll
    for (int mt = 0; mt < 2; ++mt) { bf16x8 a;
#pragma unroll
        for (int j = 0; j < 8; ++j) a[j] = (8 * q + j <= 16 * mt + fr) ? (short)0x3F80 : (short)0;
        LA[mt] = a; }
    if (F.tid < 128) { const int t = F.tid >> 3, c = F.tid & 7; *(LAS unsigned*)(L + PAM + t * AP + 32 + c * 4) = 0u; }
    v4u pre[3];
    const int c0 = 8 * cg;
#define HP_LOAD(c_) do { const size_t o_ = ((size_t)b * SEQ + 32 * (c_) + lrow) * 1024 + cb + lpart * 8; pre[0] = *(const v4u*)(QHp + o_); pre[1] = *(const v4u*)(LFp + o_); pre[2] = *(const v4u*)(IHp + o_); } while (0)
#define HP_PUT(buf_) do { _Pragma("unroll") for (int a_ = 0; a_ < 3; ++a_) *(LAS v4u*)(L + PRAW + ((buf_) * 3 + a_) * TILE + lrow * QP + lpart * 16) = pre[a_]; } while (0)
    HP_LOAD(c0); HP_PUT(0);
    __syncthreads();
    HP_LOAD(c0 + 1);
#pragma unroll 1
    for (int i = 0; i < 8; ++i) {
        const int c = c0 + i;
        const size_t row0 = (size_t)b * SEQ + 32 * c;
        const LAS unsigned char* R = L + PRAW + (i & 1) * 3 * TILE;
        LAS unsigned char* O = L + POUT + (i & 1) * 3 * TILE;
        f32x4 bacc[2]; bf16x4 q4[2], l4[2];
        { const LAS unsigned char* p = R + TILE + (8 * q + tq) * QP + trc;
          const bf16x4 lo = vtr(p), hi = vtr(p + 4 * QP);
#pragma unroll
          for (int mt = 0; mt < 2; ++mt) { const LAS unsigned char* po = R + (16 * mt + 4 * q + tq) * QP + trc; q4[mt] = vtr(po); l4[mt] = vtr(po + TILE); }
          const bf16x8 lb = __builtin_shufflevector(lo, hi, 0, 1, 2, 3, 4, 5, 6, 7);
#pragma unroll
          for (int mt = 0; mt < 2; ++mt) bacc[mt] = __builtin_amdgcn_mfma_f32_16x16x32_bf16(LA[mt], lb, (f32x4){0.f, 0.f, 0.f, 0.f}, 0, 0, 0); }
        const float blast = __shfl(bacc[1][3], 48 + fr);
#pragma unroll
        for (int mt = 0; mt < 2; ++mt)
#pragma unroll
            for (int r = 0; r < 4; ++r) { const float bb = bacc[mt][r], lf = bf2f((bf16)l4[mt][r]), qv = bf2f((bf16)q4[mt][r]);
                const float kk = 1.0f - __builtin_amdgcn_exp2f(lf * LOG2E), eb = __builtin_amdgcn_exp2f(bb * LOG2E);
                const int t = 16 * mt + 4 * q + r;
                *(LAS unsigned short*)(O + t * QP + kcol * 2) = (unsigned short)(cvt_pk_bf16(qv * eb, 0.f) & 0xffffu);
                *(LAS unsigned short*)(L + PKT + t * QP + kcol * 2) = (unsigned short)(cvt_pk_bf16(kk * __builtin_amdgcn_exp2f(fminf(-bb * LOG2E, 120.f)), 0.f) & 0xffffu);
                *(LAS unsigned short*)(O + TILE + t * QP + kcol * 2) = (unsigned short)(cvt_pk_bf16(kk * __builtin_amdgcn_exp2f((blast - bb) * LOG2E), 0.f) & 0xffffu); }
        DD[((size_t)b * (SEQ / 32) + c) * 1024 + cb + kcol] = __builtin_amdgcn_exp2f(blast * LOG2E);
        LBAR();
        if (w < 3) {
            const int ti = (w + 1) >> 1, si = w >> 1;
            f32x4 am = (f32x4){0.f, 0.f, 0.f, 0.f};
            bf16x8 ka[4], qa[4];
#pragma unroll
            for (int Tk = 0; Tk < 4; ++Tk) { ka[Tk] = *(const LAS bf16x8*)(L + PKT + (16 * si + fr) * QP + (32 * Tk + 8 * q) * 2); qa[Tk] = *(const LAS bf16x8*)(O + (16 * ti + fr) * QP + (32 * Tk + 8 * q) * 2); }
#pragma unroll
            for (int Tk = 0; Tk < 4; ++Tk) am = __builtin_amdgcn_mfma_f32_16x16x32_bf16(ka[Tk], qa[Tk], am, 0, 0, 0);
            const int t = 16 * ti + fr;
#pragma unroll
            for (int r = 0; r < 4; ++r) am[r] = (16 * si + 4 * q + r <= t) ? am[r] : 0.f;
            u32x2 aw; aw.x = cvt_pk_bf16(am[0], am[1]); aw.y = cvt_pk_bf16(am[2], am[3]);
            *(LAS u32x2*)(L + PAM + t * AP + (16 * si + 4 * q) * 2) = aw;
        }
        LBAR();
        { const LAS unsigned char* p = R + 2 * TILE + (8 * q + tq) * QP + trc; const bf16x4 lo = vtr(p), hi = vtr(p + 4 * QP);
          const bf16x8 vfrag = __builtin_shufflevector(lo, hi, 0, 1, 2, 3, 4, 5, 6, 7);
          bf16x8 amf[2];
#pragma unroll
          for (int mt = 0; mt < 2; ++mt) amf[mt] = *(const LAS bf16x8*)(L + PAM + (16 * mt + fr) * AP + q * 16);
#pragma unroll
          for (int mt = 0; mt < 2; ++mt) { const f32x4 oi = __builtin_amdgcn_mfma_f32_16x16x32_bf16(amf[mt], vfrag, (f32x4){0.f, 0.f, 0.f, 0.f}, 0, 0, 0);
#pragma unroll
              for (int r = 0; r < 4; ++r) *(LAS unsigned short*)(O + 2 * TILE + (16 * mt + 4 * q + r) * QP + kcol * 2) = (unsigned short)(cvt_pk_bf16(oi[r], 0.f) & 0xffffu); } }
        HP_PUT((i + 1) & 1);
        LBAR();
        HP_LOAD((i + 2 < 8 ? c + 2 : c0 + 7));
        { const size_t go = (row0 + lrow) * 1024 + cb + lpart * 8; const LAS unsigned char* op = O + lrow * QP + lpart * 16;
          *(v4u*)(QHo + go) = *(const LAS v4u*)op; *(v4u*)(LFo + go) = *(const LAS v4u*)(op + TILE); *(v4u*)(OI + go) = *(const LAS v4u*)(op + 2 * TILE); }
    }
#undef HP_LOAD
#undef HP_PUT
    __syncthreads();
}
constexpr int SRAW = 0, SDD = 10 * TILE, SSS = SDD + 1024, SOT = SSS + 2048;
static_assert(SOT + 2 * TILE <= RING_BYTES, "HGRN scan LDS map");
template <int VAR = 0> __device__ __forceinline__ void hgrn_seq_unit(Frame& F, int b, int h, int dummy = 0) {
    const bf16* SRC[5] = {(const bf16*)(F.ws + WS_QH), (const bf16*)(F.ws + WS_LF), (const bf16*)(F.ws + WS_IH), (const bf16*)((const unsigned char*)F.out + 64 * MiB), (const bf16*)(F.ws + WS_SOG)};
    const float* DD = (const float*)((const unsigned char*)F.out + 96 * MiB);
    bf16* OH = dummy ? (bf16*)(F.ws + 251 * MiB) : (bf16*)F.out + 1024;
    LAS unsigned char* L = F.lds + RING_OFF;
    const int lane = F.lane, w = F.wave, fr = lane & 15, q = lane >> 4, tq = fr >> 2, tp = fr & 3;
    const int kcol = 16 * w + fr, cb = h * 128;
    const int lrow = F.tid >> 4, lpart = F.tid & 15;
    const int trc = (16 * w + 4 * tp) * 2;
    float gv[8];
#pragma unroll
    for (int i = 0; i < 8; ++i) gv[i] = F.hg[8 * lpart + i];
    f32x4 S[8];
#pragma unroll
    for (int T = 0; T < 8; ++T) S[T] = (f32x4){0.f, 0.f, 0.f, 0.f};
    v4u preA[5], preB[5]; f32x4 predA = (f32x4){0.f, 0.f, 0.f, 0.f}, predB = predA;
#define HS_LOAD(c_, pre, pred) do { const size_t o_ = ((size_t)b * SEQ + 32 * (c_) + lrow) * 1024 + cb + lpart * 8; \
        _Pragma("unroll") for (int a_ = 0; a_ < 5; ++a_) pre[a_] = *(const v4u*)(SRC[a_] + o_); \
        pred = *(const f32x4*)(DD + ((size_t)b * (SEQ / 32) + (c_)) * 1024 + cb + 4 * (F.tid & 31)); } while (0)
#define HS_PUT(buf_, pre, pred) do { _Pragma("unroll") for (int a_ = 0; a_ < 4; ++a_) *(LAS v4u*)(L + SRAW + ((buf_) * 5 + a_) * TILE + lrow * QP + lpart * 16) = pre[a_]; \
        if (F.tid < 32) *(LAS f32x4*)(L + SDD + (buf_) * 512 + 16 * F.tid) = pred; } while (0)
    HS_LOAD(0, preA, predA); HS_PUT(0, preA, predA);
    v4u sgA = preA[4], sgB = preA[4];
    __syncthreads();
    HS_LOAD(1, preA, predA); HS_LOAD(2, preB, predB);
#define HS_NORM_STORE(p_, sg_, row_) do { const v4u ov_ = *(const LAS v4u*)(L + SOT + (p_) * TILE + lrow * QP + lpart * 16); float v_[8], g_[8]; pg8::unpack8(ov_, v_); pg8::unpack8(sg_, g_); \
        float ss_ = (v_[0] * v_[0] + v_[1] * v_[1]) + (v_[2] * v_[2] + v_[3] * v_[3]) + (v_[4] * v_[4] + v_[5] * v_[5]) + (v_[6] * v_[6] + v_[7] * v_[7]); ss_ = row16_sum(ss_); \
        const float rs_ = __builtin_amdgcn_rsqf(ss_ * (1.f / 128.f) + EPS); \
        v4u w_; w_.x = cvt_pk_bf16(v_[0] * rs_ * gv[0] * g_[0], v_[1] * rs_ * gv[1] * g_[1]); w_.y = cvt_pk_bf16(v_[2] * rs_ * gv[2] * g_[2], v_[3] * rs_ * gv[3] * g_[3]); \
        w_.z = cvt_pk_bf16(v_[4] * rs_ * gv[4] * g_[4], v_[5] * rs_ * gv[5] * g_[5]); w_.w = cvt_pk_bf16(v_[6] * rs_ * gv[6] * g_[6], v_[7] * rs_ * gv[7] * g_[7]); \
        *(v4u*)(OH + ((row_) + lrow) * 2048 + cb + lpart * 8) = w_; } while (0)
#define HS_STEP(c, pre, pred) { \
        const int par = c & 1; \
        const size_t row0 = (size_t)b * SEQ + 32 * c; \
        const LAS unsigned char* R = L + SRAW + par * 5 * TILE; \
        bf16x8 sb[4]; \
        _Pragma("unroll") \
        for (int Tk = 0; Tk < 4; ++Tk) sb[Tk] = mk8(cvt_pk_bf16(S[2 * Tk][0], S[2 * Tk][1]), cvt_pk_bf16(S[2 * Tk][2], S[2 * Tk][3]), cvt_pk_bf16(S[2 * Tk + 1][0], S[2 * Tk + 1][1]), cvt_pk_bf16(S[2 * Tk + 1][2], S[2 * Tk + 1][3])); \
        bf16x8 vfrag, qpf[2][4], khf[8]; f32x4 ddf[8]; bf16x4 oi4[2]; \
        { const LAS unsigned char* p = R + 2 * TILE + (8 * q + tq) * QP + trc; const bf16x4 lo = vtr(p), hi = vtr(p + 4 * QP); vfrag = __builtin_shufflevector(lo, hi, 0, 1, 2, 3, 4, 5, 6, 7); } \
        _Pragma("unroll") \
        for (int mt = 0; mt < 2; ++mt) { \
        _Pragma("unroll") \
            for (int Tk = 0; Tk < 4; ++Tk) { const LAS unsigned char* qp = R + (16 * mt + fr) * QP + (32 * Tk + 4 * q) * 2; \
                const bf16x4 lo = *(const LAS bf16x4*)qp, hi = *(const LAS bf16x4*)(qp + 32); qpf[mt][Tk] = __builtin_shufflevector(lo, hi, 0, 1, 2, 3, 4, 5, 6, 7); } \
            const LAS unsigned char* po = R + 3 * TILE + (16 * mt + 4 * q + tq) * QP + trc; oi4[mt] = vtr(po); } \
        _Pragma("unroll") \
        for (int T = 0; T < 8; ++T) { ddf[T] = *(const LAS f32x4*)(L + SDD + par * 512 + (16 * T + 4 * q) * 4); \
            const LAS unsigned char* kp = R + TILE + (8 * q + tq) * QP + (16 * T + 4 * tp) * 2; const bf16x4 lo = vtr(kp), hi = vtr(kp + 4 * QP); khf[T] = __builtin_shufflevector(lo, hi, 0, 1, 2, 3, 4, 5, 6, 7); } \
        f32x4 o[2]; \
        _Pragma("unroll") \
        for (int mt = 0; mt < 2; ++mt) o[mt] = (f32x4){bf2f((bf16)oi4[mt][0]), bf2f((bf16)oi4[mt][1]), bf2f((bf16)oi4[mt][2]), bf2f((bf16)oi4[mt][3])}; \
        _Pragma("unroll") \
        for (int Tk = 0; Tk < 4; ++Tk) \
        _Pragma("unroll") \
            for (int mt = 0; mt < 2; ++mt) { if (VAR < 2) o[mt] = __builtin_amdgcn_mfma_f32_16x16x32_bf16(qpf[mt][Tk], sb[Tk], o[mt], 0, 0, 0); else asm volatile("" :: "v"(qpf[mt][Tk]), "v"(sb[Tk])); } \
        _Pragma("unroll") \
        for (int T = 0; T < 8; ++T) { if (VAR < 2) S[T] = __builtin_amdgcn_mfma_f32_16x16x32_bf16(khf[T], vfrag, S[T] * ddf[T], 0, 0, 0); else { S[T] = S[T] * ddf[T]; asm volatile("" :: "v"(khf[T]), "v"(vfrag)); } } \
        HS_PUT(par ^ 1, pre, pred); \
        LBAR(); \
        if (c > 0 && VAR != 1 && VAR != 3) HS_NORM_STORE(par ^ 1, sgA, row0 - 32); \
        _Pragma("unroll") \
        for (int mt = 0; mt < 2; ++mt) \
        _Pragma("unroll") \
            for (int r = 0; r < 4; ++r) *(LAS unsigned short*)(L + SOT + par * TILE + (16 * mt + 4 * q + r) * QP + kcol * 2) = (unsigned short)(cvt_pk_bf16(o[mt][r], 0.f) & 0xffffu); \
        sgA = sgB; sgB = pre[4]; \
        HS_LOAD((c + 3 < SEQ / 32 ? c + 3 : SEQ / 32 - 1), pre, pred); }
#pragma unroll 1
    for (int c2 = 0; c2 < SEQ / 32; c2 += 2) { HS_STEP((c2), preA, predA) HS_STEP((c2 + 1), preB, predB) }
#undef HS_STEP
#undef HS_LOAD
#undef HS_PUT
    __syncthreads();
    HS_NORM_STORE(1, sgA, (size_t)b * SEQ + SEQ - 32);
    __syncthreads();
}
#undef HS_NORM_STORE

__device__ __forceinline__ void p2a_mixers(Frame& F, int wq, int dummy = 0, int mask = 3) {
    LAS int* slot = (LAS int*)(F.lds + X_NTILE + 64);
    for (;;) {
        __syncthreads();
        if (F.tid == 0) slot[0] = (int)__hip_atomic_fetch_add(F.ctl + wq, 1u, RLX_AGENT);
        __syncthreads();
        const int u = slot[0];
        if (u >= 1024) break;
        if (u < 512) { if (mask & 1) hgrn_prep_unit(F, u >> 6, (u >> 3) & 7, u & 7, dummy); }
        else if (mask & 2) { const int a = u - 512; attn_unit(F, a >> 6, (a >> 2) & 15, a & 3); }
    }
}
}
constexpr int CONV_U1 = 640, CONV_U2 = 1024;
__device__ __forceinline__ void conv_queue(Frame& F, int wq, int lo, int hi, int maxn = 1 << 30) {
    LAS int* slot = (LAS int*)(F.lds + X_NTILE + 64);
    for (int n_ = 0; n_ < maxn; ++n_) {
        __syncthreads();
        if (F.tid == 0) slot[0] = lo + (int)__hip_atomic_fetch_add(F.ctl + wq, 1u, RLX_AGENT);
        __syncthreads();
        const int u = slot[0];
        if (u >= hi) break;
        const int base = u * 32 + F.wave * 4;
#pragma unroll 1
        for (int k = 0; k < 4; ++k) moe_weight_item(F, base + k);
    }
    __syncthreads();
}
namespace mix {
}
using mix::p2a_mixers;
#endif
__device__ __forceinline__ int lane_id() { return (int)__builtin_amdgcn_mbcnt_hi(~0u, __builtin_amdgcn_mbcnt_lo(~0u, 0u)); }
template <int CTRL> __device__ __forceinline__ float dppf(float x) { return __builtin_bit_cast(float, __builtin_amdgcn_update_dpp(0, __builtin_bit_cast(int, x), CTRL, 0xF, 0xF, true)); }
__device__ __forceinline__ float wave_sum(float v) {
    v += dppf<0xB1>(v); v += dppf<0x4E>(v); v += dppf<0x124>(v); v += dppf<0x128>(v);
    v += __shfl_xor(v, 16); v += __shfl_xor(v, 32);
    return v;
}
__device__ __forceinline__ void p0_prologue(Frame& F) {
    LAS float* scr = (LAS float*)(F.lds + RING_OFF + F.wave * 16384);
    const int gw = F.vcu * NWAVES + F.wave, NGW = F.G * NWAVES;
    bf16* WinT = (bf16*)(F.ws + WS_WIN); bf16* WbaT = (bf16*)(F.ws + WS_WBA); bf16* WbhT = (bf16*)(F.ws + WS_WBH); bf16* WoutT = (bf16*)(F.ws + WS_WOUT);
    constexpr int I_IN = 32 * 176, I_G8 = 32 * 128, I_BR = 16 * 64, I_OUT = 32 * 64;
    constexpr int NITEMS = I_IN + I_G8 + (P0_ALLW ? 2 * I_BR + I_OUT : 0);
    for (int it = gw; it < NITEMS; it += NGW) {
        int r = it;
        if (r < I_IN) { p0_transpose_item(F.w_in, DM, INW, WinT, r / 176, r % 176, 0, scr, F.lane, LDP1); continue; } r -= I_IN;
        if (r < I_G8) { p0_transpose_item(F.w_in + 5632, DM, INW, (bf16*)(F.ws + WS_WG8), r / 128, r % 128, 0, scr, F.lane, DM, 0, nullptr, 64.f); continue; } r -= I_G8;
        if (r < I_BR) { p0_transpose_item(F.wba, 1024, DM, WbaT, r / 64, r % 64, 0, scr, F.lane, DM, 0); continue; } r -= I_BR;
        if (r < I_BR) { p0_transpose_item(F.wbh, 1024, DM, WbaT, r / 64, r % 64, 0, scr, F.lane, DM, 1024); continue; } r -= I_BR;
        p0_transpose_item(F.wout, DM, DM, WoutT, r / 64, r % 64, 0, scr, F.lane, 0, 0, nullptr, P4_F8 ? 64.f : 0.f);
    }
    bf16* XN = (bf16*)F.out;
    for (int m = gw; m < TOK; m += NGW) {
        const GAS f32x4* xr = (const GAS f32x4*)(F.x + (size_t)m * DM) + F.lane; const GAS f32x4* gr = (const GAS f32x4*)F.g_mix + F.lane;
        f32x4 v[8]; float s = 0.f;
#pragma unroll
        for (int j = 0; j < 8; ++j) { v[j] = xr[64 * j]; s += (v[j].x * v[j].x + v[j].y * v[j].y) + (v[j].z * v[j].z + v[j].w * v[j].w); }
        const float rstd = __builtin_amdgcn_rsqf(wave_sum(s) * (1.f / DM) + EPS);
        GAS unsigned long long* o8 = (GAS unsigned long long*)(XN + (size_t)m * LDP1) + F.lane;
        GAS unsigned* o4 = (GAS unsigned*)(F.ws + WS_XN8 + (size_t)m * DM) + F.lane;
#pragma unroll
        for (int j = 0; j < 8; ++j) { const f32x4 g = gr[64 * j]; const float a0 = v[j].x * rstd * g.x, a1 = v[j].y * rstd * g.y, a2 = v[j].z * rstd * g.z, a3 = v[j].w * rstd * g.w;
            o8[64 * j] = (unsigned long long)pk2(a0, a1) | ((unsigned long long)pk2(a2, a3) << 32);
            int q8 = __builtin_amdgcn_cvt_pk_fp8_f32(a0, a1, 0, false); q8 = __builtin_amdgcn_cvt_pk_fp8_f32(a2, a3, q8, true); o4[64 * j] = (unsigned)q8; }
    }
    const int gt = F.vcu * (NWAVES * 64) + F.tid, NGT = F.G * NWAVES * 64;
    float* LB = (float*)(F.ws + WS_LB);
    for (int c = gt; c < 1024; c += NGT) LB[c] = 1.f / (1.f + expf(F.lbl[1024 + c] - F.lbl[c]));
    bf16* WB = (bf16*)(F.ws + WS_WR2);
    for (int id = gt; id < 64 * 3 * 2 * 4 * 16 * 8; id += NGT) {
        const int i = id & 7, col = (id >> 3) & 15, q = (id >> 7) & 3, hl = (id >> 9) & 1, nt = (id >> 10) % 3, j = id / 3072;
        const int k = 32 * j + 8 * q + i, e = 16 * nt + col;
        float w = 0.f; if (e < 32) w = F.w_re[k * 32 + e]; else if (e < 36) w = F.w_rg[k * 4 + (e - 32)];
        w *= F.g_moe[k];
        const unsigned hi = f2bf(w); const float rem = w - __uint_as_float(hi << 16);
        WB[id] = (bf16)(hl ? f2bf(rem) : hi);
    }
}
__device__ __forceinline__ void moe_tables(Frame& F) {
    LAS int* tile_e = (LAS int*)(F.lds + X_TILE_E); LAS int* pstart = (LAS int*)(F.lds + X_PSTART); LAS int* ecnt = (LAS int*)(F.lds + X_ECNT); LAS int* ntile = (LAS int*)(F.lds + X_NTILE);
    __syncthreads();
    if (F.tid < NEXP) { int c = (int)__hip_atomic_load(F.ctl + CW_ECNT + 64 * F.tid, RLX_AGENT); ecnt[F.tid] = c < 0 ? 0 : (c > TOK ? TOK : c); }
    __syncthreads();
    if (F.tid == 0) { int ps = 0, nt = 0;
        for (int e = 0; e < NEXP; ++e) { const int c = ecnt[e]; pstart[e] = ps; const int nte = (c + 255) >> 8; for (int k = 0; k < nte && nt < 160; ++k) tile_e[nt++] = e; ps += nte * 256; }
        pstart[NEXP] = ps; ntile[0] = nt; }
    __syncthreads();
}
__device__ __forceinline__ void p5_router(Frame& F, int cnt_base = CW_ECNT, size_t tokl_off = WS_TOKL) {
    const bf16* H1 = (const bf16*)(F.ws + WS_HN); const bf16* WB = (const bf16*)(F.ws + WS_WR2);
    float* RSTD = (float*)(F.ws + WS_RSTD); int* TOKE = (int*)(F.ws + WS_TOKE); int* TOKP = (int*)(F.ws + WS_TOKP); float* TOKW = (float*)(F.ws + WS_TOKW); int* TOKL = (int*)(F.ws + tokl_off);
    const int w4 = F.wave & 3, half = F.wave >> 2;
    LAS float* lg = (LAS float*)(F.lds + RING_OFF + w4 * 4096);
    LAS float* lgp = (LAS float*)(F.lds + RING_OFF + 16384 + w4 * 4096);
    const int lane = lane_id();
    const int r = lane & 15, kq = lane >> 4;
    for (int rt = F.vcu * 4 + w4; rt < TOK / 16; rt += F.G * 4) {
        const int row = rt * 16 + r;
        const bf16* hrow = H1 + (size_t)row * DM + 8 * kq + 1024 * half;
        f32x4 acc[3]; acc[0] = acc[1] = acc[2] = (f32x4){0.f, 0.f, 0.f, 0.f}; float ss = 0.f;
#pragma unroll 4
        for (int j = 0; j < 32; ++j) {
            const v4u aw = *(const v4u*)(hrow + 32 * j);
            float hf[8]; pg8::unpack8(aw, hf);
            ss += (hf[0] * hf[0] + hf[1] * hf[1]) + (hf[2] * hf[2] + hf[3] * hf[3]) + (hf[4] * hf[4] + hf[5] * hf[5]) + (hf[6] * hf[6] + hf[7] * hf[7]);
            const bf16x8 a = __builtin_bit_cast(bf16x8, aw);
            const bf16* wb = WB + (size_t)(j + 32 * half) * 3072 + (kq * 16 + r) * 8;
#pragma unroll
            for (int nt = 0; nt < 3; ++nt) { const bf16x8 bh = *(const bf16x8*)(wb + nt * 1024), bl = *(const bf16x8*)(wb + nt * 1024 + 512);
                acc[nt] = __builtin_amdgcn_mfma_f32_16x16x32_bf16(a, bh, acc[nt], 0, 0, 0); acc[nt] = __builtin_amdgcn_mfma_f32_16x16x32_bf16(a, bl, acc[nt], 0, 0, 0); }
        }
        if (half == 1) {
#pragma unroll
            for (int nt = 0; nt < 3; ++nt)
#pragma unroll
                for (int i = 0; i < 4; ++i) lgp[lane * 13 + 4 * nt + i] = acc[nt][i];
            lgp[lane * 13 + 12] = ss; }
        __syncthreads();
        if (half == 1) { __syncthreads(); continue; }
#pragma unroll
        for (int nt = 0; nt < 3; ++nt)
#pragma unroll
            for (int i = 0; i < 4; ++i) acc[nt][i] += lgp[lane * 13 + 4 * nt + i];
        ss += lgp[lane * 13 + 12];
        ss += __shfl_xor(ss, 16); ss += __shfl_xor(ss, 32);
        const float rstd = __builtin_amdgcn_rsqf(ss * (1.f / DM) + EPS);
#pragma unroll
        for (int nt = 0; nt < 3; ++nt)
#pragma unroll
            for (int i = 0; i < 4; ++i) lg[(4 * kq + i) * 49 + 16 * nt + r] = acc[nt][i];
        LDS_WAIT(); asm volatile("" ::: "memory");
        if (lane < 16) {
            const LAS float* L = lg + lane * 49;
            float gl[4]; float gmax = -3.0e38f; int grp = 0;
#pragma unroll
            for (int g = 0; g < 4; ++g) { gl[g] = L[32 + g] * rstd + F.b_rg[g]; if (gl[g] > gmax) { gmax = gl[g]; grp = g; } }
            float gs = 0.f;
#pragma unroll
            for (int g = 0; g < 4; ++g) gs += expf(gl[g] - gmax);
            const float psel = 1.0f / gs;
            float el[8]; float m1 = -3.0e38f; int i1 = 0;
#pragma unroll
            for (int i = 0; i < 8; ++i) { el[i] = L[grp * 8 + i] * rstd + F.b_re[grp * 8 + i]; if (el[i] > m1) { m1 = el[i]; i1 = i; } }
            float m2 = -3.0e38f; int i2 = 0;
#pragma unroll
            for (int i = 0; i < 8; ++i) { if (i != i1 && el[i] > m2) { m2 = el[i]; i2 = i; } }
            const float e2 = expf(m2 - m1), inv = 1.0f / (1.0f + e2);
            const int t = rt * 16 + lane, ex0 = grp * 8 + i1, ex1 = grp * 8 + i2;
            const int p0 = (int)__hip_atomic_fetch_add(F.ctl + cnt_base + 64 * ex0, 1u, RLX_AGENT);
            const int p1 = (int)__hip_atomic_fetch_add(F.ctl + cnt_base + 64 * ex1, 1u, RLX_AGENT);
            TOKL[ex0 * TOK + p0] = t; TOKL[ex1 * TOK + p1] = t;
            TOKE[2 * t] = ex0; TOKE[2 * t + 1] = ex1; TOKP[2 * t] = p0; TOKP[2 * t + 1] = p1;
            TOKW[2 * t] = psel * inv; TOKW[2 * t + 1] = psel * e2 * inv; RSTD[t] = rstd;
        }
        __syncthreads();
    }
}
__device__ __forceinline__ void p8_final(Frame& F, bool have_tables = false) {
    if (!have_tables) moe_tables(F);
    const int lane = lane_id();
    const LAS int* pstart = (const LAS int*)(F.lds + X_PSTART);
    const unsigned char* Y = F.ws + WS_Y; const int* TOKE = (const int*)(F.ws + WS_TOKE); const int* TOKP = (const int*)(F.ws + WS_TOKP); const float* TOKW = (const float*)(F.ws + WS_TOKW);
    const int gw = F.vcu * NWAVES + F.wave, NGW = F.G * NWAVES;
    f32x4 gf[8];
#pragma unroll
    for (int j = 0; j < 4; ++j) { gf[2 * j] = *(const f32x4*)(F.g_fin + 512 * j + 8 * lane); gf[2 * j + 1] = *(const f32x4*)(F.g_fin + 512 * j + 8 * lane + 4); }
    int t = gw;
    int e0 = 0, e1 = 0, p0 = 0, p1 = 0; float w0 = 0.f, w1 = 0.f;
    if (t < TOK) { e0 = TOKE[2 * t]; e1 = TOKE[2 * t + 1]; p0 = TOKP[2 * t]; p1 = TOKP[2 * t + 1]; w0 = TOKW[2 * t]; w1 = TOKW[2 * t + 1]; }
    for (; t < TOK; t += NGW) {
        const size_t s0 = (size_t)(pstart[e0 & 31] + p0), s1 = (size_t)(pstart[e1 & 31] + p1);
        const float cw0 = w0 * 0.0625f, cw1 = w1 * 0.0625f;
        float* orow = F.out + (size_t)t * DM + 8 * lane; const bf16* hrow = (const bf16*)(F.ws + WS_HN) + (size_t)t * DM + 8 * lane;
        const unsigned char* y0 = Y + s0 * DM + 8 * lane; const unsigned char* y1 = Y + s1 * DM + 8 * lane;
        v4u hv[4]; unsigned long long ya[4], yb[4];
#pragma unroll
        for (int j = 0; j < 4; ++j) { hv[j] = *(const v4u*)(hrow + 512 * j); ya[j] = *(const unsigned long long*)(y0 + 512 * j); yb[j] = *(const unsigned long long*)(y1 + 512 * j); }
        const int tn = t + NGW;
        if (tn < TOK) { e0 = TOKE[2 * tn]; e1 = TOKE[2 * tn + 1]; p0 = TOKP[2 * tn]; p1 = TOKP[2 * tn + 1]; w0 = TOKW[2 * tn]; w1 = TOKW[2 * tn + 1]; }
        float v[4][8]; float ss = 0.f;
#pragma unroll
        for (int j = 0; j < 4; ++j) { float fa[8], fb[8]; pg8::unpack8_f8(ya[j], fa); pg8::unpack8_f8(yb[j], fb);
            pg8::unpack8(hv[j], v[j]);
#pragma unroll
            for (int i = 0; i < 8; ++i) { v[j][i] += cw0 * fa[i] + cw1 * fb[i]; ss += v[j][i] * v[j][i]; } }
        const float rstd = __builtin_amdgcn_rsqf(wave_sum(ss) * (1.f / DM) + EPS);
#pragma unroll
        for (int j = 0; j < 4; ++j) {
            *(f32x4*)(orow + 512 * j) = (f32x4){v[j][0] * rstd * gf[2 * j].x, v[j][1] * rstd * gf[2 * j].y, v[j][2] * rstd * gf[2 * j].z, v[j][3] * rstd * gf[2 * j].w};
            *(f32x4*)(orow + 512 * j + 4) = (f32x4){v[j][4] * rstd * gf[2 * j + 1].x, v[j][5] * rstd * gf[2 * j + 1].y, v[j][6] * rstd * gf[2 * j + 1].z, v[j][7] * rstd * gf[2 * j + 1].w};
        }
    }
}
#if MK_NAIVE_MIX
__device__ __forceinline__ float bf2f(bf16 h) { return __uint_as_float((unsigned)h << 16); }
__global__ void __launch_bounds__(256) naive_attn(const bf16* QA, const bf16* KA, const bf16* VA, const float* sinks, bf16* OA) {
    const int idx = blockIdx.x * 256 + threadIdx.x, t = idx >> 4, hq = idx & 15, hkv = hq >> 2, pos = t & (SEQ - 1);
    float q[64];
#pragma unroll
    for (int d = 0; d < 64; ++d) q[d] = bf2f(QA[(size_t)t * 1024 + hq * 64 + d]);
    const int lo = pos - 127 < 0 ? 0 : pos - 127;
    const float sink2 = sinks[hq] * pg8::LOG2E; float m = sink2;
    for (int p = lo; p <= pos; ++p) { const bf16* kr = KA + (size_t)(t - pos + p) * 256 + hkv * 64; float s = 0.f;
#pragma unroll
        for (int d = 0; d < 64; ++d) s += q[d] * bf2f(kr[d]);
        m = fmaxf(m, s); }
    float den = exp2f(sink2 - m); float o[64];
#pragma unroll
    for (int d = 0; d < 64; ++d) o[d] = 0.f;
    for (int p = lo; p <= pos; ++p) { const bf16* kr = KA + (size_t)(t - pos + p) * 256 + hkv * 64; const bf16* vr = VA + (size_t)(t - pos + p) * 256 + hkv * 64; float s = 0.f;
#pragma unroll
        for (int d = 0; d < 64; ++d) s += q[d] * bf2f(kr[d]);
        const float w = exp2f(s - m); den += w;
#pragma unroll
        for (int d = 0; d < 64; ++d) o[d] += w * bf2f(vr[d]); }
    const float inv = 1.f / den;
#pragma unroll
    for (int d = 0; d < 64; ++d) OA[(size_t)t * 1024 + hq * 64 + d] = (bf16)f2bf(o[d] * inv);
}
__global__ void __launch_bounds__(128) naive_hgrn(const bf16* QH, const bf16* LF, const bf16* IH, const bf16* SOG, const float* hg, bf16* OH) {
    __shared__ float sf[128], sq[128], red[2];
    const int b = blockIdx.x >> 3, h = blockIdx.x & 7, v = threadIdx.x;
    float S[128];
#pragma unroll
    for (int k = 0; k < 128; ++k) S[k] = 0.f;
    for (int t = 0; t < SEQ; ++t) {
        const size_t row = (size_t)b * SEQ + t;
        sf[v] = expf(bf2f(LF[row * 1024 + h * 128 + v])); sq[v] = bf2f(QH[row * 1024 + h * 128 + v]);
        const float iv = bf2f(IH[row * 1024 + h * 128 + v]);
        __syncthreads();
        float o = 0.f;
#pragma unroll
        for (int k = 0; k < 128; ++k) { const float f = sf[k]; S[k] = f * S[k] + (1.f - f) * iv; o += S[k] * sq[k]; }
        float ss = o * o;
#pragma unroll
        for (int off = 1; off < 64; off <<= 1) ss += __shfl_xor(ss, off);
        if ((v & 63) == 0) red[v >> 6] = ss;
        __syncthreads();
        const float rstd = 1.0f / sqrtf((red[0] + red[1]) * (1.f / 128.f) + EPS);
        OH[row * 1024 + h * 128 + v] = (bf16)f2bf(o * rstd * hg[v] * bf2f(SOG[row * 1024 + h * 128 + v]));
    }
}
#endif

__device__ __forceinline__ void group_census_post(Frame& F) { if (threadIdx.x == 0) (void)xb_add((unsigned*)(F.ctl + CW_GCEN + 16 * (blockIdx.x & 7u) + xb_xcc_id()), 1u); }
__device__ __forceinline__ void group_barrier(Frame& F, int k) {
    asm volatile("s_waitcnt vmcnt(0)" ::: "memory");
    __syncthreads();
    if (threadIdx.x == 0) {
        unsigned* bar = (unsigned*)(F.ctl + CW_BAR);
        const unsigned g = blockIdx.x & 7u, x = xb_xcc_id(), target = (gridDim.x + 7u - g) >> 3;
        const unsigned mine = xb_ld((unsigned*)(F.ctl + CW_GCEN + 16 * g + x));
        unsigned* top = (unsigned*)(F.ctl + CW_GTOP + 64 * (8 * k + g));
        __builtin_amdgcn_s_waitcnt(0);
        const unsigned old = xb_add((unsigned*)(F.ctl + CW_GARR + 128 * k + 16 * g + x), 1u);
        if (old + 1u == mine) {
            __builtin_amdgcn_fence(__ATOMIC_RELEASE, "agent");
            asm volatile("s_waitcnt vmcnt(0)" ::: "memory");
            (void)xb_add(top, mine);
        }
        XB_SPIN(xb_ld(top) < target, bar);
        __builtin_amdgcn_fence(__ATOMIC_ACQUIRE, "agent");
        asm volatile("s_waitcnt vmcnt(0)" ::: "memory");
    }
    __syncthreads();
}
struct Args { const float* in[18]; float* out; unsigned char* ws; int ph_lo, ph_hi; };
__global__ void __launch_bounds__(NWAVES * 64, 2) fwd(Args args) {
    extern __shared__ __attribute__((aligned(16))) unsigned char lds[];
    Frame F;
    F.lds = (LAS unsigned char*)lds;
    F.MISC = (volatile LAS unsigned*)(F.lds + MISC_OFF);
    F.tid = threadIdx.x; F.lane = F.tid & 63; F.wave = __builtin_amdgcn_readfirstlane(F.tid >> 6);
    F.G = gridDim.x; { const int bx = blockIdx.x; F.vcu = (F.G % 8 == 0) ? (bx % 8) * (F.G / 8) + bx / 8 : bx; }
    F.ws = args.ws; F.ctl = (gu32*)(args.ws + WS_CTL); F.out = args.out;
    F.x = args.in[0]; F.w_in = args.in[1]; F.sinks = args.in[2]; F.lbl = args.in[3]; F.hg = args.in[4]; F.wba = args.in[5]; F.wbh = args.in[6]; F.wout = args.in[7];
    F.g_mix = args.in[8]; F.g_moe = args.in[9]; F.w_rg = args.in[10]; F.b_rg = args.in[11]; F.w_re = args.in[12]; F.b_re = args.in[13]; F.w1 = args.in[14]; F.w3 = args.in[15]; F.w2 = args.in[16]; F.g_fin = args.in[17];
    if (F.tid < 16) F.MISC[F.tid] = 0u;
    __syncthreads();
    XcdBarrier bar; bar.bar = (unsigned*)(F.ctl + CW_BAR); bar.x = 0; bar.st = nullptr;
    if (ONE_LAUNCH) bar = xcd_barrier_post((unsigned*)(F.ctl + CW_BAR), F.MISC + 8);
    if (ONE_LAUNCH) group_census_post(F);
#define GRID_BAR() do { if (ONE_LAUNCH) xcd_barrier(bar); } while (0)
    const int lo = args.ph_lo, hi = args.ph_hi;
#define IN(k) (lo <= (k) && (k) < hi)
#define BOTH(k) (IN(k) && IN((k) + 1))
    unsigned char* ws = args.ws;
    bf16* XN = (bf16*)F.out; bf16* OAH = (bf16*)F.out;

#ifndef DBG_REP
#define DBG_REP -1
#endif
#ifndef DBG_EPI2
#define DBG_EPI2 0
#endif
#ifndef WGM_P1
#define WGM_P1 4
#endif
#ifndef WGM_P1F
#define WGM_P1F 4
#endif
#ifndef WGM_P3A
#define WGM_P3A 2
#endif
#ifndef WGM_P3
#define WGM_P3 2
#endif
#ifndef WGM_P4
#define WGM_P4 2
#endif
#ifndef GROUP_BAR
#define GROUP_BAR 1
#endif
#ifndef P34_STAGGER
#define P34_STAGGER 0
#endif
#ifndef P1_HEAD
#define P1_HEAD 0
#endif
#ifndef P1_SWAP
#define P1_SWAP 2
#endif
    if (IN(0)) { p0_prologue(F); if (DBG_REP == 0) { GRID_BAR(); p0_prologue(F); } if (BOTH(0)) GRID_BAR(); }

    if (IN(1)) {
        pg8::Gemm g{XN, (const bf16*)(ws + WS_WIN), TOK, 5632, DM, LDP1, LDP1}; pg8::StaticOrder S; S.init(TOK, 5632, F.G, (int)blockIdx.x, WGM_P1);
        pg8::EpiProj E{(bf16*)(ws + WS_QA), (bf16*)(ws + WS_KA), (bf16*)(ws + WS_VA), (bf16*)(ws + WS_QH), (bf16*)(ws + WS_LF), (bf16*)(ws + WS_IH), (bf16*)(ws + WS_SOG), (bf16*)(ws + WS_GATE), (const float*)(ws + WS_LB), 0};
        if (P1_HEAD > 0) conv_queue(F, CW_WQ + 32, 0, CONV_U1, ((int)blockIdx.x >> 6) * P1_HEAD);
        pg8::Gemm g8{(const bf16*)(ws + WS_XN8), (const bf16*)(ws + WS_WG8), 0x79797979, 0x7f7f7f7f, DM, DM, DM};
        pg8::StaticOrder S8; S8.init(TOK, 4096, F.G, (int)blockIdx.x, WGM_P1F);
        pg8::EpiProj E8 = E; E8.pn_off = 22;
        if (P1_SWAP == 2 || (P1_SWAP == 1 && (blockIdx.x & 1))) {
            pg8::gemm_phase_f8<pg8::EpiProj, pg8::StaticOrder, true, false>(F.lds + RING_OFF, g8, S8, E8);
            pg8::gemm_phase<pg8::EpiProj, pg8::StaticOrder, true, false>(F.lds + RING_OFF, g, S, E);
        } else {
            pg8::gemm_phase<pg8::EpiProj, pg8::StaticOrder, true, false, false, (DBG_EPI2 & 1)>(F.lds + RING_OFF, g, S, E);
            pg8::gemm_phase_f8<pg8::EpiProj, pg8::StaticOrder, true, false, false, (DBG_EPI2 & 2)>(F.lds + RING_OFF, g8, S8, E8);
        }
        if (!P0_ALLW) conv_queue(F, CW_WQ + 24, 1536, 1568);
        conv_queue(F, CW_WQ + 32, 0, CONV_U1);
        if (BOTH(1)) GRID_BAR();
    }

    if (IN(2)) {
#if !MK_NAIVE_MIX
        p2a_mixers(F, CW_WQ);
        GRID_BAR();
        if (blockIdx.x < 64) mix::hgrn_seq_unit<0>(F, (int)blockIdx.x >> 3, (int)blockIdx.x & 7);
        else {
            pg8::StaticOrder S; S.init(TOK, DM, F.G - 64, (int)blockIdx.x - 64, WGM_P3A);
            pg8::Gemm g{OAH, (const bf16*)(ws + WS_WBA), TOK, DM, 1024, DM, DM};
            pg8::EpiGate<true> E{(bf16*)(ws + WS_MRG), ws + WS_GATE, nullptr};
            pg8::gemm_phase<pg8::EpiGate<true>, pg8::StaticOrder, true, false>(F.lds + RING_OFF, g, S, E);
            if (!P0_ALLW) conv_queue(F, CW_WQ + 40, 1568, 1664);
            conv_queue(F, CW_WQ + 16, CONV_U1, CONV_U2);
        }
#endif
        if (BOTH(2)) GRID_BAR();
    }

    const bool grp_ok = ONE_LAUNCH && GROUP_BAR && WGM_P3 == WGM_P4 && (F.G & 7) == 0;
    if (IN(3)) {
        if (grp_ok && P34_STAGGER > 0 && ((int)blockIdx.x & 1)) conv_queue(F, CW_WQ + 48, CONV_U2, 1536, P34_STAGGER);
        pg8::StaticOrder S; S.init(TOK, DM, F.G, (int)blockIdx.x, WGM_P3);
        { pg8::Gemm g{OAH + 1024, (const bf16*)(ws + WS_WBA) + 1024, TOK, DM, 1024, DM, DM};
          pg8::EpiGate<false> E{(bf16*)(ws + WS_MRG), ws + WS_GATE, P4_F8 ? ws + WS_MRG8 : nullptr};
          pg8::gemm_phase<pg8::EpiGate<false>, pg8::StaticOrder, true, false>(F.lds + RING_OFF, g, S, E); }
        if (BOTH(3)) { if (grp_ok) group_barrier(F, 0); else GRID_BAR(); }
    }

    if (DBG_REP == 3 && IN(3)) {
        pg8::StaticOrder S; S.init(TOK, DM, F.G, (int)blockIdx.x, WGM_P3);
        { pg8::Gemm g{OAH + 1024, (const bf16*)(ws + WS_WBA) + 1024, TOK, DM, 1024, DM, DM};
          pg8::EpiGate<false> E{(bf16*)(ws + WS_MRG), ws + WS_GATE, P4_F8 ? ws + WS_MRG8 : nullptr};
          pg8::gemm_phase<pg8::EpiGate<false>, pg8::StaticOrder, true, false>(F.lds + RING_OFF, g, S, E); }
        GRID_BAR();
    }

    if (IN(4)) {
        pg8::StaticOrder S; S.init(TOK, DM, F.G, (int)blockIdx.x, WGM_P4);
        pg8::EpiRes E{F.x, (bf16*)(ws + WS_HN), (unsigned char*)F.out + HN8_OFF};
        if (P4_F8) { pg8::Gemm g{(const bf16*)(ws + WS_MRG8), (const bf16*)(ws + WS_WOUT), 0x79797979, 0x7c7c7c7c, DM, DM, DM};
            pg8::gemm_phase_f8<pg8::EpiRes, pg8::StaticOrder, false, false>(F.lds + RING_OFF, g, S, E); }
        else { pg8::Gemm g{(const bf16*)(ws + WS_MRG), (const bf16*)(ws + WS_WOUT), TOK, DM, DM, DM, DM};
            pg8::gemm_phase<pg8::EpiRes, pg8::StaticOrder, false, false, false, (DBG_EPI2 & 4)>(F.lds + RING_OFF, g, S, E); }
        if (BOTH(4)) { if (grp_ok) group_barrier(F, 1); else GRID_BAR(); }
    }

    if (IN(5)) { if (DBG_REP == 5) { p5_router(F, CW_ECNT + 64 * 40, WS_Y); GRID_BAR(); } p5_router(F);
        if (grp_ok && P34_STAGGER > 0 && !((int)blockIdx.x & 1)) conv_queue(F, CW_WQ + 48, CONV_U2, 1536, P34_STAGGER);
        if (BOTH(5)) GRID_BAR(); }

    if (IN(6)) {
        moe_tables(F);
        const LAS int* tile_e = (const LAS int*)(F.lds + X_TILE_E); const LAS int* pstart = (const LAS int*)(F.lds + X_PSTART); const LAS int* ecnt = (const LAS int*)(F.lds + X_ECNT);
        LAS int* tokt = (LAS int*)(F.lds + X_TOKT); LAS float* rst = (LAS float*)(F.lds + X_RST);
        const int ntile = *(const LAS int*)(F.lds + X_NTILE);
        pg8::MoeOrder S{4, ntile * 4, F.G, F.vcu, DM, tile_e, tokt};
        const int* TOKL = (const int*)(ws + WS_TOKL); const float* RSTD = (const float*)(ws + WS_RSTD);
        { int tokv[MAXU];
#pragma unroll
          for (int ui = 0; ui < MAXU; ++ui) { pg8::Unit u; tokv[ui] = 0;
              if (F.tid < 256 && S.next(ui, u)) { const int e = tile_e[u.pm], pos = u.pm * 256 + F.tid - pstart[e]; tokv[ui] = TOKL[e * TOK + (pos < ecnt[e] ? pos : 0)] & (TOK - 1); } }
#pragma unroll
          for (int ui = 0; ui < MAXU; ++ui) if (F.tid < 256) { tokt[ui * 256 + F.tid] = tokv[ui]; rst[ui * 256 + F.tid] = RSTD[tokv[ui]]; } }
        __syncthreads();
        pg8::Gemm g{(const bf16*)((unsigned char*)F.out + HN8_OFF), (const bf16*)(ws + WS_W13), 0x79797979, 0x7f7f7f7f, DM, DM, DM};
        pg8::EpiSwiGLU E{ws + WS_HB, rst};
        pg8::gemm_phase_f8<pg8::EpiSwiGLU, pg8::MoeOrder, true, true, false, (DBG_EPI2 & 8)>(F.lds + RING_OFF, g, S, E);
        conv_queue(F, CW_WQ + 48, CONV_U2, 1536);
        if (BOTH(6)) GRID_BAR();
    }

    if (IN(7)) {
        if (!(ONE_LAUNCH && IN(6))) moe_tables(F);
        const LAS int* tile_e = (const LAS int*)(F.lds + X_TILE_E); const int ntile = *(const LAS int*)(F.lds + X_NTILE);
        pg8::MoeOrder S{8, ntile * 8, F.G, F.vcu, 0, tile_e, nullptr};
        pg8::Gemm g{(const bf16*)(ws + WS_HB), (const bf16*)(ws + WS_W2), 0x7a7a7a7a, 0x7f7f7f7f, DEXP, DEXP, DEXP};
        pg8::EpiY E{ws + WS_Y};
        pg8::gemm_phase_f8<pg8::EpiY, pg8::MoeOrder, true, false, false, (DBG_EPI2 & 16)>(F.lds + RING_OFF, g, S, E);
        if (BOTH(7)) GRID_BAR();
    }

    if (IN(8)) p8_final(F, ONE_LAUNCH && IN(6));
#undef IN
#undef BOTH
#undef GRID_BAR
}
#if defined(DBG_STOP_AFTER)
__global__ void __launch_bounds__(256) dbg_dump(const unsigned char* ws, const bf16* d_scr, float* out, int which) {
    const size_t i = (size_t)blockIdx.x * 256 + threadIdx.x; const size_t t = i >> 11; const int c = (int)(i & 2047);
    auto f = [](bf16 h) { return __uint_as_float((unsigned)h << 16); };
    float v = 0.f;
    if (which == 1) {
        const bf16* QA = (const bf16*)(ws + WS_QA); const bf16* KA = (const bf16*)(ws + WS_KA); const bf16* VA = (const bf16*)(ws + WS_VA); const bf16* QH = (const bf16*)(ws + WS_QH);
        const bf16* LF = (const bf16*)(ws + WS_LF); const bf16* IH = (const bf16*)(ws + WS_IH); const bf16* SOG = (const bf16*)(ws + WS_SOG); const bf16* GATE = (const bf16*)(ws + WS_GATE);
        v = f(QA[t * 1024 + (c & 1023)]) + f(KA[t * 256 + (c & 255)]) + f(VA[t * 256 + (c & 255)]) + f(QH[t * 1024 + (c & 1023)]) + f(LF[t * 1024 + (c & 1023)]) + f(IH[t * 1024 + (c & 1023)]) + f(SOG[t * 1024 + (c & 1023)]) + f(GATE[t * 4096 + c]) + f(GATE[t * 4096 + 2048 + c]);
    } else if (which == 2) { v = f(d_scr[i]); }
    else if (which == 3) { v = f(((const bf16*)(ws + WS_MRG))[i]); }
    else if (which == 0) {
        v = f(d_scr[i]) + f(((const bf16*)(ws + WS_WIN))[i % 19922944]) + f(((const bf16*)(ws + WS_W13))[i]) + f(((const bf16*)(ws + WS_W13))[i + 33554432]) + f(((const bf16*)(ws + WS_W2))[i])
          + f(((const bf16*)(ws + WS_WBA))[i % 2097152]) + f(((const bf16*)(ws + WS_WBH))[i % 2097152]) + f(((const bf16*)(ws + WS_WOUT))[i % 4194304]) + ((const float*)(ws + WS_LB))[i & 1023] + ((const float*)(ws + WS_WR2))[i % 98304];
    }
    out[i] = v;
}
#endif
extern "C" void kernel_launch(void* const* d_in, const int* in_sizes, int n_in, void* d_out, int out_size, void* d_ws, size_t ws_size, hipStream_t stream) {
    static int grid = 0;
    if (grid == 0) {
        if (n_in != 18 || in_sizes[0] != TOK * DM || out_size != TOK * DM || ws_size < WS_END) { fprintf(stderr, "kernel_launch: built for 18 inputs, x and out of %d floats, >= %zu bytes of workspace; got n_in %d, in0 %d, out %d, ws %zu; nothing launched\n", TOK * DM, (size_t)WS_END, n_in, n_in > 0 ? in_sizes[0] : -1, out_size, ws_size); grid = -1; return; }
        int dev = 0, cus = 0, per_cu = 0;
        if (hipGetDevice(&dev) != hipSuccess || hipDeviceGetAttribute(&cus, hipDeviceAttributeMultiprocessorCount, dev) != hipSuccess) { fprintf(stderr, "kernel_launch: hipGetDevice / hipDeviceGetAttribute failed; nothing launched\n"); grid = -1; return; }
        if (hipFuncSetAttribute((const void*)fwd, hipFuncAttributeMaxDynamicSharedMemorySize, LDS_BYTES) != hipSuccess) { fprintf(stderr, "kernel_launch: hipFuncSetAttribute failed\n"); grid = -1; return; }
        if (hipOccupancyMaxActiveBlocksPerMultiprocessor(&per_cu, (const void*)fwd, NWAVES * 64, LDS_BYTES) != hipSuccess || per_cu < 1) { fprintf(stderr, "kernel_launch: occupancy query reports %d workgroups per CU\n", per_cu); }
        (void)hipGetLastError();
        if (cus != 256) { fprintf(stderr, "kernel_launch: built for a 256-CU device (one resident workgroup per CU), found %d CUs; nothing launched\n", cus); grid = -1; return; }
        grid = cus;
    }
    if (grid < 0) return;
    if (hipMemsetAsync((char*)d_ws + WS_CTL, 0, CTL_ZERO_BYTES, stream) != hipSuccess) { fprintf(stderr, "kernel_launch: hipMemsetAsync failed\n"); return; }
    Args a{};
    for (int i = 0; i < 18; ++i) a.in[i] = (const float*)d_in[i];
    a.out = (float*)d_out; a.ws = (unsigned char*)d_ws;
    if (MK_N_LAUNCHES == 1) {
        a.ph_lo = 0; a.ph_hi = N_PHASES;
        hipLaunchKernelGGL(fwd, dim3(grid), dim3(NWAVES * 64), LDS_BYTES, stream, a);
    } else {
        for (int ph = 0; ph < N_PHASES; ++ph) {
#if MK_NAIVE_MIX
            if (ph == 2) {
                unsigned char* ws = (unsigned char*)d_ws; bf16* OA = (bf16*)d_out; bf16* OH = OA + (size_t)TOK * 1024;
                hipLaunchKernelGGL(naive_attn, dim3(TOK * 16 / 256), dim3(256), 0, stream, (const bf16*)(ws + WS_QA), (const bf16*)(ws + WS_KA), (const bf16*)(ws + WS_VA), (const float*)d_in[2], OA);
                hipLaunchKernelGGL(naive_hgrn, dim3(64), dim3(128), 0, stream, (const bf16*)(ws + WS_QH), (const bf16*)(ws + WS_LF), (const bf16*)(ws + WS_IH), (const bf16*)(ws + WS_SOG), (const float*)d_in[4], OH);
                continue;
            }
#endif
#if defined(DBG_NO_MOE)
            if (ph >= 5 && ph <= 7) continue;
#endif
#if defined(DBG_STOP_AFTER)
            if (ph > DBG_STOP_AFTER) {
                unsigned char* ws = (unsigned char*)d_ws;
                if (DBG_STOP_AFTER == 2 || DBG_STOP_AFTER == 0) (void)hipMemcpyAsync(ws + WS_Y, d_out, (size_t)TOK * 2048 * 2, hipMemcpyDeviceToDevice, stream);
                if (DBG_STOP_AFTER != 4) hipLaunchKernelGGL(dbg_dump, dim3(TOK * 2048 / 256), dim3(256), 0, stream, (const unsigned char*)ws, (const bf16*)(ws + WS_Y), (float*)d_out, (int)DBG_STOP_AFTER);
                break;
            }
#endif
            a.ph_lo = ph; a.ph_hi = ph + 1;
            hipLaunchKernelGGL(fwd, dim3(grid), dim3(NWAVES * 64), LDS_BYTES, stream, a);
        }
    }
    hipError_t e = hipGetLastError();
    if (e != hipSuccess) fprintf(stderr, "kernel_launch: launch failed: %s\n", hipGetErrorName(e));
}
```

```cpp
#define MK_N_LAUNCHES 1
#define MK_NAIVE_MIX 0
#include <hip/hip_runtime.h>
#include <cstdio>
#include <cstdint>
namespace pg8 {
#define PG8_LAS __attribute__((address_space(3)))
typedef unsigned short bf16_t;
typedef short bf16x8 __attribute__((ext_vector_type(8)));
typedef float f32x4 __attribute__((ext_vector_type(4)));
typedef unsigned u32x4 __attribute__((ext_vector_type(4)));
constexpr int BM = 256, BK = 64, HALF = 128, HTB = HALF * BK * 2  , STAGE_BYTES = 8 * HTB, NXCD = 8, WGM = 4;

__host__ __device__ __forceinline__ int lds_byte(int r, int c) { const int st = (r >> 4) * 2 + (c >> 5), rr = r & 15, cc = c & 31, ob = rr * 64 + cc * 2; return st * 1024 + (ob ^ (((ob >> 9) & 1) << 5)); }
__host__ __device__ __forceinline__ void stage_rc(int b, int& R, int& C) { const int st = b / 1024, sb = b % 1024, swz = sb ^ (((sb >> 9) & 1) << 5); R = (st >> 1) * 16 + swz / 64; C = (st & 1) * 32 + (swz % 64) / 2; }
__host__ __device__ __forceinline__ int perm32(int rho) { const int n = rho >> 4, i = rho & 15; return 8 * (i >> 2) + 4 * n + (i & 3); }

struct Unit { int pm, pn, pb, ui; };
struct Gemm { const bf16_t* A; const bf16_t* Bt; int M, N, K, lda, ldb; };

struct StaticOrder {
    int nM, nN, nwg, G, c, wgm;
    __host__ __device__ void init(int M, int N, int G_, int c_, int wgm_ = WGM) { nM = M / BM; nN = N / BM; nwg = nM * nN; G = G_; c = c_; wgm = wgm_; }
    __host__ __device__ bool next(int i, Unit& u) const {
        const long L = (long)i * G + c; if (L >= nwg) return false;
        int wgid = (int)L; { const int q = nwg / NXCD, r = nwg % NXCD, xcd = wgid % NXCD, off = wgid / NXCD; wgid = (xcd < r ? xcd * (q + 1) : r * (q + 1) + (xcd - r) * q) + off; }
        const int nig = wgm * nN, gid = wgid / nig, fm = gid * wgm, gsz = (nM - fm) < wgm ? (nM - fm) : wgm;
        u.pm = fm + ((wgid % nig) % gsz); u.pn = (wgid % nig) / gsz; u.pb = u.pn; u.ui = i; return true;
    }
    __device__ __forceinline__ void a_ready(const Unit&) const {}
    __device__ __forceinline__ void done(const Unit&) const {}
    __device__ __forceinline__ unsigned arow_off(const Unit&, int) const { return 0u; }
};

typedef float f32x2_t __attribute__((ext_vector_type(2))); typedef __bf16 bf16x2_t __attribute__((ext_vector_type(2)));
__device__ __forceinline__ unsigned cvt_pk_bf16(float lo, float hi) { f32x2_t v = {lo, hi}; bf16x2_t b = __builtin_convertvector(v, bf16x2_t); return __builtin_bit_cast(unsigned, b); }
__device__ __forceinline__ float bf_lo(unsigned w) { return __uint_as_float(w << 16); }
__device__ __forceinline__ float bf_hi(unsigned w) { return __uint_as_float(w & 0xffff0000u); }
template <class Epi, class Sched, bool ALIGN_EPI = false, bool GATHER = false, bool MIDHOOK = false, int EREP = 0>
__device__ __forceinline__ void gemm_phase(PG8_LAS unsigned char* lds, const Gemm g, const Sched& S, const Epi& E) {
    const int tid = threadIdx.x, wid = __builtin_amdgcn_readfirstlane(tid >> 6), lane = tid & 63, wr = wid >> 2, wc = wid & 3, fr = lane & 15, fq = lane >> 4;
    const int K = g.K, nt = K / BK, lda = g.lda, ldb = g.ldb;
    unsigned voffB[2]; int RA[2], CA[2];
#pragma unroll
    for (int i = 0; i < 2; ++i) { int R, C; stage_rc(tid * 16 + i * 8192, R, C); const int Rb = Epi::PERM ? ((R & ~31) + perm32(R & 31)) : R;
        RA[i] = R; CA[i] = C; voffB[i] = (unsigned)(Rb * ldb + C) * 2u; }
    const size_t kstep = (size_t)(BK * 2);
    const size_t hstep = (size_t)HALF * ldb * 2;
    const size_t tstep = 2 * hstep;
    const size_t tstepA = (size_t)BM * lda * 2;
    const unsigned ldsw = (unsigned)wid * 1024u;
    const int aoff = lds_byte(wr * 64 + fr, fq * 8), boff = lds_byte(wc * 32 + fr, fq * 8);
#define PG8_SA(b, h) (((b) * 2 + (h)) * HTB)
#define PG8_SB(b, h) ((4 + (b) * 2 + (h)) * HTB)
#define PG8_STAGE(bufoff, gbase, voff) do { _Pragma("unroll") for (int _i = 0; _i < 2; ++_i) \
        __builtin_amdgcn_global_load_lds((const unsigned*)((const char*)(gbase) + (voff)[_i]), (PG8_LAS unsigned*)(lds + (bufoff) + ldsw + _i * 8192), 16, 0, 0); } while (0)
#define PG8_LDA(dst, b, h) do { _Pragma("unroll") for (int m = 0; m < 4; ++m) _Pragma("unroll") for (int k = 0; k < 2; ++k) dst[m][k] = *(const PG8_LAS bf16x8*)(lds + PG8_SA(b, h) + aoff + m * 2048 + k * 1024); } while (0)
#define PG8_LDB(dst, b, h) do { _Pragma("unroll") for (int n = 0; n < 2; ++n) _Pragma("unroll") for (int k = 0; k < 2; ++k) dst[n][k] = *(const PG8_LAS bf16x8*)(lds + PG8_SB(b, h) + boff + n * 2048 + k * 1024); } while (0)
#define PG8_MMA(ai, bj, At, Bt) do { __builtin_amdgcn_s_setprio(1); _Pragma("unroll") for (int m = 0; m < 4; ++m) _Pragma("unroll") for (int n = 0; n < 2; ++n) _Pragma("unroll") for (int k = 0; k < 2; ++k) \
        acc[ai][bj][m][n] = __builtin_amdgcn_mfma_f32_16x16x32_bf16(Bt[n][k], At[m][k], acc[ai][bj][m][n], 0, 0, 0); __builtin_amdgcn_s_setprio(0); } while (0)
#define PG8_WAIT_V(n) asm volatile("s_waitcnt vmcnt(" #n ")" ::: "memory")
#define PG8_WAIT_L(n) asm volatile("s_waitcnt lgkmcnt(" #n ")" ::: "memory")
#define PG8_BAR __builtin_amdgcn_s_barrier()
#define PG8_SCHED __builtin_amdgcn_sched_barrier(0)
#define PG8_SETA(u, v, base) do { if constexpr (GATHER) { base = (const char*)g.A; \
        _Pragma("unroll") for (int h_ = 0; h_ < 2; ++h_) _Pragma("unroll") for (int i_ = 0; i_ < 2; ++i_) v[h_][i_] = S.arow_off(u, h_ * HALF + RA[i_]) + (unsigned)CA[i_] * 2u; } \
      else { base = (const char*)g.A + (size_t)(u).pm * tstepA; \
        _Pragma("unroll") for (int h_ = 0; h_ < 2; ++h_) _Pragma("unroll") for (int i_ = 0; i_ < 2; ++i_) v[h_][i_] = (unsigned)((RA[i_] + h_ * HALF) * lda + CA[i_]) * 2u; } } while (0)
    Unit cur, nxt; int ui = 0;
    if (!S.next(0, cur)) return;
    f32x4 acc[2][2][4][2];
#pragma unroll
    for (int a = 0; a < 2; ++a)
#pragma unroll
        for (int b = 0; b < 2; ++b)
#pragma unroll
            for (int m = 0; m < 4; ++m)
#pragma unroll
                for (int n = 0; n < 2; ++n) acc[a][b][m][n] = (f32x4){0.f, 0.f, 0.f, 0.f};
    bf16x8 At[4][2], B0[2][2], B1[2][2];
    const char* cA; unsigned vc[2][2], vn[2][2];
    PG8_SETA(cur, vc, cA);
    const char* cB = (const char*)g.Bt + (size_t)cur.pb * tstep;
    S.a_ready(cur);
    PG8_STAGE(PG8_SB(0, 0), cB, voffB); PG8_STAGE(PG8_SB(0, 1), cB + hstep, voffB); PG8_STAGE(PG8_SA(0, 0), cA, vc[0]); PG8_STAGE(PG8_SA(0, 1), cA, vc[1]);
    if (wr == 1) PG8_BAR;
    PG8_WAIT_V(2); PG8_BAR;
    PG8_STAGE(PG8_SB(1, 0), cB + kstep, voffB); PG8_STAGE(PG8_SA(1, 0), cA + kstep, vc[0]); PG8_STAGE(PG8_SB(1, 1), cB + hstep + kstep, voffB);
    PG8_WAIT_V(6); PG8_BAR;
    for (;;) {
        const bool has_next = S.next(ui + 1, nxt);
        const char* nA = cA; const char* nB = cB;
#pragma unroll
        for (int h_ = 0; h_ < 2; ++h_)
#pragma unroll
            for (int i_ = 0; i_ < 2; ++i_) vn[h_][i_] = vc[h_][i_];
        if (has_next) { PG8_SETA(nxt, vn, nA); nB = (const char*)g.Bt + (size_t)nxt.pb * tstep; }
#define PG8_KBODY \
            const bool last = (t == nt - 2); \
            const char* a1 = cA + (size_t)(t + 1) * kstep; \
            const char* a2 = last ? nA : cA + (size_t)(t + 2) * kstep; const char* b2 = last ? nB : cB + (size_t)(t + 2) * kstep; \
            const char* a3 = a2 + kstep; const char* b3 = b2 + kstep; \
            unsigned v2[2][2]; \
            _Pragma("unroll") \
            for (int h_ = 0; h_ < 2; ++h_) \
            _Pragma("unroll") \
                for (int i_ = 0; i_ < 2; ++i_) v2[h_][i_] = (GATHER && last) ? vn[h_][i_] : vc[h_][i_]; \
            if (last && has_next) S.a_ready(nxt); \
            PG8_LDB(B0, 0, 0); PG8_LDB(B1, 0, 1); PG8_SCHED; PG8_LDA(At, 0, 0); PG8_STAGE(PG8_SA(1, 1), a1, vc[1]); \
            PG8_WAIT_V(8); PG8_WAIT_L(0); PG8_BAR; PG8_MMA(0, 0, At, B0); PG8_MMA(0, 1, At, B1); PG8_BAR; PG8_SCHED; \
            PG8_LDA(At, 0, 1); PG8_STAGE(PG8_SB(0, 0), b2, voffB); PG8_STAGE(PG8_SB(0, 1), b2 + hstep, voffB); PG8_STAGE(PG8_SA(0, 0), a2, v2[0]); \
            PG8_WAIT_V(8); PG8_WAIT_L(0); PG8_BAR; PG8_MMA(1, 0, At, B0); PG8_MMA(1, 1, At, B1); PG8_BAR; PG8_SCHED; \
            PG8_LDB(B0, 1, 0); PG8_LDB(B1, 1, 1); PG8_SCHED; PG8_LDA(At, 1, 0); PG8_STAGE(PG8_SA(0, 1), a2, v2[1]); \
            PG8_WAIT_V(8); PG8_WAIT_L(0); PG8_BAR; PG8_MMA(0, 0, At, B0); PG8_MMA(0, 1, At, B1); PG8_BAR; PG8_SCHED; \
            PG8_LDA(At, 1, 1); PG8_STAGE(PG8_SB(1, 0), b3, voffB); PG8_STAGE(PG8_SB(1, 1), b3 + hstep, voffB); PG8_STAGE(PG8_SA(1, 0), a3, v2[0]); \
            PG8_WAIT_V(8); PG8_WAIT_L(0); PG8_BAR; PG8_MMA(1, 0, At, B0); PG8_MMA(1, 1, At, B1); PG8_BAR; PG8_SCHED;
        if constexpr (MIDHOOK) {
            for (int t = 0; t < (nt >> 1); t += 2) { PG8_KBODY }
            E.mid(acc, cur, wr, wc, fr, fq);
            for (int t = (nt >> 1); t < nt; t += 2) { PG8_KBODY }
        } else {
            for (int t = 0; t < nt; t += 2) { PG8_KBODY }
        }
#undef PG8_KBODY
        if constexpr (ALIGN_EPI) { if (wr == 0) PG8_BAR; }
        E(acc, cur, wr, wc, fr, fq);
        if constexpr (EREP != 0) { asm volatile("" ::: "memory"); E(acc, cur, wr, wc, fr, fq); }
        S.done(cur);
        if (!has_next) break;
#pragma unroll
        for (int a = 0; a < 2; ++a)
#pragma unroll
            for (int b = 0; b < 2; ++b)
#pragma unroll
                for (int m = 0; m < 4; ++m)
#pragma unroll
                    for (int n = 0; n < 2; ++n) acc[a][b][m][n] = (f32x4){0.f, 0.f, 0.f, 0.f};
        cur = nxt; cA = nA; cB = nB; ++ui;
#pragma unroll
        for (int h_ = 0; h_ < 2; ++h_)
#pragma unroll
            for (int i_ = 0; i_ < 2; ++i_) vc[h_][i_] = vn[h_][i_];
        if constexpr (ALIGN_EPI) { if (wr == 1) PG8_BAR; }
    }
    PG8_WAIT_V(0);
    if constexpr (!ALIGN_EPI) { if (wr == 0) PG8_BAR; }
    PG8_BAR;
#undef PG8_SA
#undef PG8_SB
#undef PG8_STAGE
#undef PG8_LDA
#undef PG8_LDB
#undef PG8_MMA
#undef PG8_WAIT_V
#undef PG8_WAIT_L
#undef PG8_BAR
#undef PG8_SCHED
#undef PG8_SETA
}
typedef int v4i_t __attribute__((ext_vector_type(4))); typedef int v8i_t __attribute__((ext_vector_type(8)));
template <class Epi, class Sched, bool ALIGN_EPI = false, bool GATHER = false, bool MIDHOOK = false, int EREP = 0>
__device__ __forceinline__ void gemm_phase_f8(PG8_LAS unsigned char* lds, const Gemm g, const Sched& S, const Epi& E) {
    const int tid = threadIdx.x, wid = __builtin_amdgcn_readfirstlane(tid >> 6), lane = tid & 63, wr = wid >> 2, wc = wid & 3, fr = lane & 15, fq = lane >> 4;
    const int K = g.K, nt = K / (2 * BK), lda = g.lda, ldb = g.ldb;
    unsigned voffB[2]; int RA[2], CA[2];
#pragma unroll
    for (int i = 0; i < 2; ++i) { int R, C; stage_rc(tid * 16 + i * 8192, R, C); const int Rb = Epi::PERM ? ((R & ~31) + perm32(R & 31)) : R;
        RA[i] = R; CA[i] = C; voffB[i] = (unsigned)(Rb * ldb + C * 2); }
    const size_t kstep = (size_t)(BK * 2);
    const size_t hstep = (size_t)HALF * ldb;
    const size_t tstep = 2 * hstep;
    const size_t tstepA = (size_t)BM * lda;
    const unsigned ldsw = (unsigned)wid * 1024u;
    const int aoff = lds_byte(wr * 64 + fr, fq * 16), boff = lds_byte(wc * 32 + fr, fq * 16);
#define PG8_SA(b, h) (((b) * 2 + (h)) * HTB)
#define PG8_SB(b, h) ((4 + (b) * 2 + (h)) * HTB)
#define PG8_STAGE(bufoff, gbase, voff) do { _Pragma("unroll") for (int _i = 0; _i < 2; ++_i) \
        __builtin_amdgcn_global_load_lds((const unsigned*)((const char*)(gbase) + (voff)[_i]), (PG8_LAS unsigned*)(lds + (bufoff) + ldsw + _i * 8192), 16, 0, 0); } while (0)
#define PG8_LDA(dst, b, h) do { _Pragma("unroll") for (int m = 0; m < 4; ++m) _Pragma("unroll") for (int k = 0; k < 2; ++k) { const v4i_t t_ = *(const PG8_LAS v4i_t*)(lds + PG8_SA(b, h) + aoff + m * 2048 + k * 16); dst[m][4 * k] = t_[0]; dst[m][4 * k + 1] = t_[1]; dst[m][4 * k + 2] = t_[2]; dst[m][4 * k + 3] = t_[3]; } } while (0)
#define PG8_LDB(dst, b, h) do { _Pragma("unroll") for (int n = 0; n < 2; ++n) _Pragma("unroll") for (int k = 0; k < 2; ++k) { const v4i_t t_ = *(const PG8_LAS v4i_t*)(lds + PG8_SB(b, h) + boff + n * 2048 + k * 16); dst[n][4 * k] = t_[0]; dst[n][4 * k + 1] = t_[1]; dst[n][4 * k + 2] = t_[2]; dst[n][4 * k + 3] = t_[3]; } } while (0)
#define PG8_MMA(ai, bj, At, Bt) do { __builtin_amdgcn_s_setprio(1); _Pragma("unroll") for (int m = 0; m < 4; ++m) _Pragma("unroll") for (int n = 0; n < 2; ++n) \
        asm volatile("v_mfma_scale_f32_16x16x128_f8f6f4 %0, %1, %2, %0, %3, %4 op_sel_hi:[0,0,0]" : "+v"(acc[ai][bj][m][n]) : "v"(Bt[n]), "v"(At[m]), "v"(scw), "v"(sca)); __builtin_amdgcn_s_setprio(0); } while (0)
#define PG8_WAIT_V(n) asm volatile("s_waitcnt vmcnt(" #n ")" ::: "memory")
#define PG8_WAIT_L(n) asm volatile("s_waitcnt lgkmcnt(" #n ")" ::: "memory")
#define PG8_BAR __builtin_amdgcn_s_barrier()
#define PG8_SCHED __builtin_amdgcn_sched_barrier(0)
#define PG8_SETA(u, v, base) do { if constexpr (GATHER) { base = (const char*)g.A; \
        _Pragma("unroll") for (int h_ = 0; h_ < 2; ++h_) _Pragma("unroll") for (int i_ = 0; i_ < 2; ++i_) v[h_][i_] = S.arow_off(u, h_ * HALF + RA[i_]) + (unsigned)CA[i_] * 2u; } \
      else { base = (const char*)g.A + (size_t)(u).pm * tstepA; \
        _Pragma("unroll") for (int h_ = 0; h_ < 2; ++h_) _Pragma("unroll") for (int i_ = 0; i_ < 2; ++i_) v[h_][i_] = (unsigned)((RA[i_] + h_ * HALF) * lda + CA[i_] * 2); } } while (0)
    Unit cur, nxt; int ui = 0;
    if (!S.next(0, cur)) return;
    f32x4 acc[2][2][4][2];
#pragma unroll
    for (int a = 0; a < 2; ++a)
#pragma unroll
        for (int b = 0; b < 2; ++b)
#pragma unroll
            for (int m = 0; m < 4; ++m)
#pragma unroll
                for (int n = 0; n < 2; ++n) acc[a][b][m][n] = (f32x4){0.f, 0.f, 0.f, 0.f};
    v8i_t At[4], B0[2], B1[2];
    int scw = g.M, sca = g.N;
    asm volatile("" : "+v"(scw), "+v"(sca));
    const char* cA; unsigned vc[2][2], vn[2][2];
    PG8_SETA(cur, vc, cA);
    const char* cB = (const char*)g.Bt + (size_t)cur.pb * tstep;
    S.a_ready(cur);
    PG8_STAGE(PG8_SB(0, 0), cB, voffB); PG8_STAGE(PG8_SB(0, 1), cB + hstep, voffB); PG8_STAGE(PG8_SA(0, 0), cA, vc[0]); PG8_STAGE(PG8_SA(0, 1), cA, vc[1]);
    if (wr == 1) PG8_BAR;
    PG8_WAIT_V(2); PG8_BAR;
    PG8_STAGE(PG8_SB(1, 0), cB + kstep, voffB); PG8_STAGE(PG8_SA(1, 0), cA + kstep, vc[0]); PG8_STAGE(PG8_SB(1, 1), cB + hstep + kstep, voffB);
    PG8_WAIT_V(6); PG8_BAR;
    for (;;) {
        const bool has_next = S.next(ui + 1, nxt);
        const char* nA = cA; const char* nB = cB;
#pragma unroll
        for (int h_ = 0; h_ < 2; ++h_)
#pragma unroll
            for (int i_ = 0; i_ < 2; ++i_) vn[h_][i_] = vc[h_][i_];
        if (has_next) { PG8_SETA(nxt, vn, nA); nB = (const char*)g.Bt + (size_t)nxt.pb * tstep; }
#define PG8_KBODY \
            const bool last = (t == nt - 2); \
            const char* a1 = cA + (size_t)(t + 1) * kstep; \
            const char* a2 = last ? nA : cA + (size_t)(t + 2) * kstep; const char* b2 = last ? nB : cB + (size_t)(t + 2) * kstep; \
            const char* a3 = a2 + kstep; const char* b3 = b2 + kstep; \
            unsigned v2[2][2]; \
            _Pragma("unroll") \
            for (int h_ = 0; h_ < 2; ++h_) \
            _Pragma("unroll") \
                for (int i_ = 0; i_ < 2; ++i_) v2[h_][i_] = (GATHER && last) ? vn[h_][i_] : vc[h_][i_]; \
            if (last && has_next) S.a_ready(nxt); \
            PG8_LDB(B0, 0, 0); PG8_LDB(B1, 0, 1); PG8_SCHED; PG8_LDA(At, 0, 0); PG8_STAGE(PG8_SA(1, 1), a1, vc[1]); \
            PG8_WAIT_V(8); PG8_WAIT_L(0); PG8_BAR; PG8_MMA(0, 0, At, B0); PG8_MMA(0, 1, At, B1); PG8_BAR; PG8_SCHED; \
            PG8_LDA(At, 0, 1); PG8_STAGE(PG8_SB(0, 0), b2, voffB); PG8_STAGE(PG8_SB(0, 1), b2 + hstep, voffB); PG8_STAGE(PG8_SA(0, 0), a2, v2[0]); \
            PG8_WAIT_V(8); PG8_WAIT_L(0); PG8_BAR; PG8_MMA(1, 0, At, B0); PG8_MMA(1, 1, At, B1); PG8_BAR; PG8_SCHED; \
            PG8_LDB(B0, 1, 0); PG8_LDB(B1, 1, 1); PG8_SCHED; PG8_LDA(At, 1, 0); PG8_STAGE(PG8_SA(0, 1), a2, v2[1]); \
            PG8_WAIT_V(8); PG8_WAIT_L(0); PG8_BAR; PG8_MMA(0, 0, At, B0); PG8_MMA(0, 1, At, B1); PG8_BAR; PG8_SCHED; \
            PG8_LDA(At, 1, 1); PG8_STAGE(PG8_SB(1, 0), b3, voffB); PG8_STAGE(PG8_SB(1, 1), b3 + hstep, voffB); PG8_STAGE(PG8_SA(1, 0), a3, v2[0]); \
            PG8_WAIT_V(8); PG8_WAIT_L(0); PG8_BAR; PG8_MMA(1, 0, At, B0); PG8_MMA(1, 1, At, B1); PG8_BAR; PG8_SCHED;
        if constexpr (MIDHOOK) {
            for (int t = 0; t < (nt >> 1); t += 2) { PG8_KBODY }
            E.mid(acc, cur, wr, wc, fr, fq);
            for (int t = (nt >> 1); t < nt; t += 2) { PG8_KBODY }
        } else {
            for (int t = 0; t < nt; t += 2) { PG8_KBODY }
        }
#undef PG8_KBODY
        asm volatile("s_nop 15\n\ts_nop 15" ::: "memory");
        if constexpr (ALIGN_EPI) { if (wr == 0) PG8_BAR; }
        E(acc, cur, wr, wc, fr, fq);
        if constexpr (EREP != 0) { asm volatile("" ::: "memory"); E(acc, cur, wr, wc, fr, fq); }
        S.done(cur);
        if (!has_next) break;
#pragma unroll
        for (int a = 0; a < 2; ++a)
#pragma unroll
            for (int b = 0; b < 2; ++b)
#pragma unroll
                for (int m = 0; m < 4; ++m)
#pragma unroll
                    for (int n = 0; n < 2; ++n) acc[a][b][m][n] = (f32x4){0.f, 0.f, 0.f, 0.f};
        cur = nxt; cA = nA; cB = nB; ++ui;
#pragma unroll
        for (int h_ = 0; h_ < 2; ++h_)
#pragma unroll
            for (int i_ = 0; i_ < 2; ++i_) vc[h_][i_] = vn[h_][i_];
        if constexpr (ALIGN_EPI) { if (wr == 1) PG8_BAR; }
    }
    PG8_WAIT_V(0);
    if constexpr (!ALIGN_EPI) { if (wr == 0) PG8_BAR; }
    PG8_BAR;
#undef PG8_SA
#undef PG8_SB
#undef PG8_STAGE
#undef PG8_LDA
#undef PG8_LDB
#undef PG8_MMA
#undef PG8_WAIT_V
#undef PG8_WAIT_L
#undef PG8_BAR
#undef PG8_SCHED
#undef PG8_SETA
}
constexpr float LOG2E = 1.4426950408889634f, LN2 = 0.6931471805599453f;
__device__ __forceinline__ float fsigmoid(float x) { return __builtin_amdgcn_rcpf(1.f + __builtin_amdgcn_exp2f(-LOG2E * x)); }
__device__ __forceinline__ u32x4 pack8(const float (&v)[8]) { u32x4 w; w.x = cvt_pk_bf16(v[0], v[1]); w.y = cvt_pk_bf16(v[2], v[3]); w.z = cvt_pk_bf16(v[4], v[5]); w.w = cvt_pk_bf16(v[6], v[7]); return w; }
__device__ __forceinline__ unsigned long long pack8_f8(const float (&v)[8]) {
    int lo = __builtin_amdgcn_cvt_pk_fp8_f32(v[0], v[1], 0, false); lo = __builtin_amdgcn_cvt_pk_fp8_f32(v[2], v[3], lo, true);
    int hi = __builtin_amdgcn_cvt_pk_fp8_f32(v[4], v[5], 0, false); hi = __builtin_amdgcn_cvt_pk_fp8_f32(v[6], v[7], hi, true);
    return (unsigned long long)(unsigned)lo | ((unsigned long long)(unsigned)hi << 32); }
__device__ __forceinline__ void unpack8_f8(const unsigned long long w, float (&v)[8]) {
    const int lo = (int)(unsigned)w, hi = (int)(unsigned)(w >> 32);
    const f32x2_t a = __builtin_amdgcn_cvt_pk_f32_fp8(lo, false), b = __builtin_amdgcn_cvt_pk_f32_fp8(lo, true), c = __builtin_amdgcn_cvt_pk_f32_fp8(hi, false), d = __builtin_amdgcn_cvt_pk_f32_fp8(hi, true);
    v[0] = a[0]; v[1] = a[1]; v[2] = b[0]; v[3] = b[1]; v[4] = c[0]; v[5] = c[1]; v[6] = d[0]; v[7] = d[1]; }
__device__ __forceinline__ void unpack8(const u32x4 w, float (&v)[8]) { v[0] = bf_lo(w.x); v[1] = bf_hi(w.x); v[2] = bf_lo(w.y); v[3] = bf_hi(w.y); v[4] = bf_lo(w.z); v[5] = bf_hi(w.z); v[6] = bf_lo(w.w); v[7] = bf_hi(w.w); }
__device__ __forceinline__ unsigned long long pack8_u8(const float (&v)[8]) {
    unsigned b[8];
#pragma unroll
    for (int j = 0; j < 8; ++j) b[j] = __float_as_uint(v[j] * 255.f + 8388608.f) & 0xffu;
    const unsigned lo = b[0] | (b[1] << 8) | (b[2] << 16) | (b[3] << 24), hi = b[4] | (b[5] << 8) | (b[6] << 16) | (b[7] << 24);
    return (unsigned long long)lo | ((unsigned long long)hi << 32); }
__device__ __forceinline__ void unpack8_u8(const unsigned long long w, float (&v)[8]) {
    const unsigned lo = (unsigned)w, hi = (unsigned)(w >> 32);
    v[0] = (float)(lo & 0xffu); v[1] = (float)((lo >> 8) & 0xffu); v[2] = (float)((lo >> 16) & 0xffu); v[3] = (float)(lo >> 24);
    v[4] = (float)(hi & 0xffu); v[5] = (float)((hi >> 8) & 0xffu); v[6] = (float)((hi >> 16) & 0xffu); v[7] = (float)(hi >> 24);
#pragma unroll
    for (int j = 0; j < 8; ++j) v[j] *= (1.f / 255.f); }
#define PG8_ACC8(v, ai, bj, m) do { const f32x4 _a = acc[ai][bj][m][0], _b = acc[ai][bj][m][1]; v[0] = _a[0]; v[1] = _a[1]; v[2] = _a[2]; v[3] = _a[3]; v[4] = _b[0]; v[5] = _b[1]; v[6] = _b[2]; v[7] = _b[3]; } while (0)

template <int MODE> __device__ __forceinline__ void proj_store(const f32x4 (&acc)[2][2][4][2], bf16_t* base, int ldc, int row0, int col0, const float* lb) {
    float lbv[2][8];
    if (MODE == 3) {
#pragma unroll
        for (int bj = 0; bj < 2; ++bj)
#pragma unroll
            for (int j = 0; j < 8; ++j) lbv[bj][j] = lb[col0 + bj * HALF + j];
    }
#pragma unroll
    for (int ai = 0; ai < 2; ++ai)
#pragma unroll
        for (int m = 0; m < 4; ++m) { bf16_t* rowp = base + (size_t)(row0 + ai * HALF + m * 16) * ldc + col0;
#pragma unroll
            for (int bj = 0; bj < 2; ++bj) { float v[8]; PG8_ACC8(v, ai, bj, m);
#pragma unroll
                for (int j = 0; j < 8; ++j) {
                    if (MODE == 0) v[j] = v[j] * (0.125f * LOG2E);
                    if (MODE == 2) v[j] = v[j] * fsigmoid(v[j]) * 0.08838834764831845f;
                    if (MODE == 3) { const float l = lbv[bj][j]; v[j] = __builtin_amdgcn_logf(l + (1.f - l) * fsigmoid(v[j])) * LN2; }
                    if (MODE == 4) v[j] = v[j] * fsigmoid(v[j]);
                    if (MODE == 5) v[j] = fsigmoid(v[j]);
                }
                if (MODE == 5) *(unsigned long long*)((unsigned char*)base + (size_t)(row0 + ai * HALF + m * 16) * ldc + col0 + bj * HALF) = pack8_u8(v);
                else *(u32x4*)(rowp + bj * HALF) = pack8(v); } }
}
struct EpiProj {
    static constexpr bool PERM = true;
    bf16_t *QA, *KA, *VA, *QH, *LF, *IH, *SOG, *GATE; const float* lb; int pn_off;
    __device__ __forceinline__ void operator()(const f32x4 (&acc)[2][2][4][2], const Unit& u, int wr, int wc, int fr, int fq) const {
        const int pn = u.pn + pn_off, row0 = u.pm * BM + wr * 64 + fr, cw = wc * 32 + 8 * fq;
        if (pn < 4)        proj_store<0>(acc, QA, 1024, row0, pn * 256 + cw, lb);
        else if (pn == 4)  proj_store<1>(acc, KA, 256, row0, cw, lb);
        else if (pn == 5)  proj_store<1>(acc, VA, 256, row0, cw, lb);
        else if (pn < 10)  proj_store<2>(acc, QH, 1024, row0, (pn - 6) * 256 + cw, lb);
        else if (pn < 14)  proj_store<3>(acc, LF, 1024, row0, (pn - 10) * 256 + cw, lb);
        else if (pn < 18)  proj_store<1>(acc, IH, 1024, row0, (pn - 14) * 256 + cw, lb);
        else if (pn < 22)  proj_store<4>(acc, SOG, 1024, row0, (pn - 18) * 256 + cw, lb);
        else               proj_store<5>(acc, GATE, 4096, row0, (pn - 22) * 256 + cw, lb);
    }
};
struct EpiGateMid {
    static constexpr bool PERM = true;
    bf16_t* MRG; const bf16_t* GATE;
    __device__ __forceinline__ void mid(f32x4 (&acc)[2][2][4][2], const Unit& u, int wr, int wc, int fr, int fq) const {
        int row0 = u.pm * BM + wr * 64 + fr, col0 = u.pn * BM + wc * 32 + 8 * fq;
        asm volatile("" : "+v"(row0), "+v"(col0));
#pragma unroll
        for (int ai = 0; ai < 2; ++ai)
#pragma unroll
            for (int m = 0; m < 4; ++m) { const bf16_t* gp = GATE + (size_t)(row0 + ai * HALF + m * 16) * 4096 + col0;
#pragma unroll
                for (int bj = 0; bj < 2; ++bj) { float g0[8], g1[8]; unpack8(*(const u32x4*)(gp + bj * HALF), g0); unpack8(*(const u32x4*)(gp + 2048 + bj * HALF), g1);
#pragma unroll
                    for (int j = 0; j < 4; ++j) { acc[ai][bj][m][0][j] *= g0[j] * __builtin_amdgcn_rcpf(g1[j]); acc[ai][bj][m][1][j] *= g0[4 + j] * __builtin_amdgcn_rcpf(g1[4 + j]); } }
                asm volatile("" ::: "memory"); }
    }
    __device__ __forceinline__ void operator()(const f32x4 (&acc)[2][2][4][2], const Unit& u, int wr, int wc, int fr, int fq) const {
        int row0 = u.pm * BM + wr * 64 + fr, col0 = u.pn * BM + wc * 32 + 8 * fq;
        asm volatile("" : "+v"(row0), "+v"(col0));
#pragma unroll
        for (int ai = 0; ai < 2; ++ai)
#pragma unroll
            for (int m = 0; m < 4; ++m) { const size_t r = (size_t)(row0 + ai * HALF + m * 16);
#pragma unroll
                for (int bj = 0; bj < 2; ++bj) { float v[8], gg[8]; PG8_ACC8(v, ai, bj, m); unpack8(*(const u32x4*)(GATE + r * 4096 + 2048 + col0 + bj * HALF), gg);
#pragma unroll
                    for (int j = 0; j < 8; ++j) v[j] *= gg[j];
                    *(u32x4*)(MRG + r * 2048 + col0 + bj * HALF) = pack8(v); } }
    }
};
template <bool FIRST> struct EpiGate {
    static constexpr bool PERM = true;
    bf16_t* MRG; const unsigned char* GATE; unsigned char* M8;
    __device__ __forceinline__ void operator()(const f32x4 (&acc)[2][2][4][2], const Unit& u, int wr, int wc, int fr, int fq) const {
        const int row0 = u.pm * BM + wr * 64 + fr, col0 = u.pn * BM + wc * 32 + 8 * fq;
#pragma unroll
        for (int ai = 0; ai < 2; ++ai) {
            unsigned long long gw[4][2]; u32x4 pw[4][2];
#pragma unroll
            for (int m = 0; m < 4; ++m)
#pragma unroll
                for (int bj = 0; bj < 2; ++bj) { const size_t r = (size_t)(row0 + ai * HALF + m * 16);
                    gw[m][bj] = *(const unsigned long long*)(GATE + r * 4096 + (FIRST ? 0 : 2048) + col0 + bj * HALF);
                    if (!FIRST) pw[m][bj] = *(const u32x4*)(MRG + r * 2048 + col0 + bj * HALF); }
#pragma unroll
            for (int m = 0; m < 4; ++m)
#pragma unroll
                for (int bj = 0; bj < 2; ++bj) { const size_t r = (size_t)(row0 + ai * HALF + m * 16);
                    float v[8], gg[8]; PG8_ACC8(v, ai, bj, m); unpack8_u8(gw[m][bj], gg);
                    if (FIRST) {
#pragma unroll
                        for (int j = 0; j < 8; ++j) v[j] *= gg[j];
                    } else { float pv[8]; unpack8(pw[m][bj], pv);
#pragma unroll
                        for (int j = 0; j < 8; ++j) v[j] = pv[j] + v[j] * gg[j]; }
                    if (!FIRST && M8) {
#pragma unroll
                        for (int j = 0; j < 8; ++j) v[j] *= 8.f;
                        *(unsigned long long*)(M8 + r * 2048 + col0 + bj * HALF) = pack8_f8(v); }
                    else *(u32x4*)(MRG + r * 2048 + col0 + bj * HALF) = pack8(v); }
        }
    }
};
struct EpiRes {
    static constexpr bool PERM = true;
    const bf16_t* XN; const float* RS0; bf16_t* HN; unsigned char* HN8;
    __device__ __forceinline__ void operator()(const f32x4 (&acc)[2][2][4][2], const Unit& u, int wr, int wc, int fr, int fq) const {
        const int row0 = u.pm * BM + wr * 64 + fr, col0 = u.pn * BM + wc * 32 + 8 * fq;
#pragma unroll
        for (int ai = 0; ai < 2; ++ai) {
            u32x4 xw[4][2]; float rs[4];
#pragma unroll
            for (int m = 0; m < 4; ++m) { rs[m] = RS0[row0 + ai * HALF + m * 16];
#pragma unroll
                for (int bj = 0; bj < 2; ++bj) xw[m][bj] = *(const u32x4*)(XN + (size_t)(row0 + ai * HALF + m * 16) * 2048 + col0 + bj * HALF); }
#pragma unroll
            for (int m = 0; m < 4; ++m)
#pragma unroll
                for (int bj = 0; bj < 2; ++bj) { const size_t off = (size_t)(row0 + ai * HALF + m * 16) * 2048 + col0 + bj * HALF;
                    float hv[8], a8[8]; unpack8(xw[m][bj], hv); PG8_ACC8(a8, ai, bj, m);
#pragma unroll
                    for (int j = 0; j < 8; ++j) hv[j] = hv[j] * rs[m] + a8[j];
                    *(u32x4*)(HN + off) = pack8(hv);
                    *(unsigned long long*)(HN8 + off) = pack8_f8(hv); }
        }
    }
};
struct EpiSwiGLU {
    static constexpr bool PERM = true;
    unsigned char* HB; const PG8_LAS float* rst;
    __device__ __forceinline__ void operator()(const f32x4 (&acc)[2][2][4][2], const Unit& u, int wr, int wc, int fr, int fq) const {
        const int rl0 = wr * 64 + fr, col0 = u.pn * 128 + wc * 32 + 8 * fq;
#pragma unroll
        for (int ai = 0; ai < 2; ++ai)
#pragma unroll
            for (int m = 0; m < 4; ++m) { const int rl = rl0 + ai * HALF + m * 16; const float rs = rst[u.ui * 256 + rl];
                float a[8], b[8]; PG8_ACC8(a, ai, 0, m); PG8_ACC8(b, ai, 1, m);
#pragma unroll
                for (int j = 0; j < 8; ++j) { const float x = a[j] * rs; a[j] = x * fsigmoid(x) * (b[j] * rs); }
                *(unsigned long long*)(HB + (size_t)(u.pm * BM + rl) * 512 + col0) = pack8_f8(a); }
    }
};
struct EpiY {
    static constexpr bool PERM = true;
    unsigned char* Y;
    __device__ __forceinline__ void operator()(const f32x4 (&acc)[2][2][4][2], const Unit& u, int wr, int wc, int fr, int fq) const {
        const int row0 = u.pm * BM + wr * 64 + fr, col0 = u.pn * BM + wc * 32 + 8 * fq;
#pragma unroll
        for (int ai = 0; ai < 2; ++ai)
#pragma unroll
            for (int m = 0; m < 4; ++m) { unsigned char* rowp = Y + (size_t)(row0 + ai * HALF + m * 16) * 2048 + col0;
#pragma unroll
                for (int bj = 0; bj < 2; ++bj) { float v[8]; PG8_ACC8(v, ai, bj, m);
#pragma unroll
                    for (int j = 0; j < 8; ++j) v[j] *= 16.f;
                    *(unsigned long long*)(rowp + bj * HALF) = pack8_f8(v); } }
    }
};
struct MoeOrder {
    int nN, total, G, c, K2; const PG8_LAS int* tile_e; const PG8_LAS int* tokt;
    __device__ __forceinline__ bool next(int i, Unit& u) const {
        const int L = i * G + c; if (L >= total) return false;
        const int mt = L / nN, pn = L - mt * nN; u.pm = mt; u.pn = pn; u.pb = tile_e[mt] * nN + pn; u.ui = i; return true;
    }
    __device__ __forceinline__ void a_ready(const Unit&) const {}
    __device__ __forceinline__ void done(const Unit&) const {}
    __device__ __forceinline__ unsigned arow_off(const Unit& u, int r) const { return (unsigned)tokt[u.ui * 256 + r] * (unsigned)K2; }
};
}
constexpr int NWAVES = 8;
#ifndef MK_N_LAUNCHES
#define MK_N_LAUNCHES 1
#endif
#ifndef MK_NAIVE_MIX
#define MK_NAIVE_MIX 0
#endif
constexpr int N_PHASES = 9;
constexpr bool ONE_LAUNCH = (MK_N_LAUNCHES == 1);

constexpr int TOK = 16384, DM = 2048, SEQ = 2048, NBATCH = 8, INW = 9728;
constexpr int NEXP = 32, DEXP = 512;
constexpr float EPS = 1e-6f;
constexpr size_t MiB = 1u << 20;
constexpr size_t WS_CTL = 0, CTL_ZERO_BYTES = 64 * 1024;
constexpr size_t WS_LB = 1 * MiB;
constexpr size_t WS_RSTD = 1 * MiB + 64 * 1024;
constexpr size_t WS_TOKE = 1 * MiB + 128 * 1024;
constexpr size_t WS_TOKP = 1 * MiB + 256 * 1024;
constexpr size_t WS_TOKW = 1 * MiB + 384 * 1024;
constexpr size_t WS_WR2 = 1 * MiB + 512 * 1024;
constexpr size_t WS_TOKL = 3 * MiB;
constexpr size_t WS_WIN = 5 * MiB, WS_WBA = 43 * MiB, WS_WBH = 47 * MiB, WS_WOUT = 51 * MiB, WS_W13 = 59 * MiB, WS_W2 = 187 * MiB;
constexpr size_t WS_QA = 251 * MiB, WS_KA = 283 * MiB, WS_VA = 291 * MiB, WS_QH = 299 * MiB, WS_LF = 331 * MiB, WS_IH = 363 * MiB, WS_SOG = 395 * MiB, WS_GATE = 427 * MiB;
constexpr size_t WS_MRG = 555 * MiB;
constexpr size_t WS_XN8 = 555 * MiB, WS_WG8 = 587 * MiB;
constexpr size_t WS_HN = 291 * MiB;
constexpr size_t WS_HB = 251 * MiB;
constexpr size_t WS_Y = 355 * MiB;
constexpr size_t WS_END = 619 * MiB;
constexpr int MAX_SLOTS = 40960;
constexpr size_t WS_XNB = 123 * MiB;
constexpr size_t WS_RS0 = 40 * MiB;
#ifndef LDP1
#define LDP1 2048
#endif
constexpr size_t WS_MRG8 = 363 * MiB;
#ifndef P0_ALLW
#define P0_ALLW 0
#endif
#ifndef P4_F8
#define P4_F8 1
#endif
constexpr size_t HN8_OFF = 64 * MiB;
constexpr int CW_TMO = 0, CW_CODE = 1;
constexpr int CW_BAR = 4096;
constexpr int CW_WQ = 8192;
constexpr int CW_ECNT = 8192 + 64;
constexpr int CW_GCEN = 14336, CW_GARR = CW_GCEN + 128, CW_GTOP = CW_GARR + 256;
static_assert((CW_ECNT + 64 * 80) <= CW_GCEN && (CW_GTOP + 64 * 16) * 4 <= (int)CTL_ZERO_BYTES, "CTL words inside the memset region");
constexpr int RING_OFF = 0, RING_BYTES = 131072;
constexpr int XOFF = RING_BYTES;
constexpr int X_TILE_E = XOFF, X_PSTART = XOFF + 1024, X_ECNT = XOFF + 1280, X_NTILE = XOFF + 1536, X_TOKT = XOFF + 2048, X_RST = XOFF + 8192, MISC_OFF = XOFF + 15360;
constexpr int MAXU = 6;
constexpr int LDS_BYTES = 147456;
static_assert(X_TOKT + MAXU * 1024 <= X_RST && X_RST + MAXU * 1024 <= MISC_OFF && MISC_OFF + 64 <= LDS_BYTES, "LDS map");

#define GAS __attribute__((address_space(1)))
#define LAS __attribute__((address_space(3)))
typedef unsigned short bf16;
typedef unsigned v4u __attribute__((ext_vector_type(4)));
typedef float f32x4 __attribute__((ext_vector_type(4)));
typedef float f32x16 __attribute__((ext_vector_type(16)));
typedef short bf16x8 __attribute__((ext_vector_type(8)));
typedef short bf16x4 __attribute__((ext_vector_type(4)));
typedef GAS unsigned gu32;
typedef GAS unsigned long long gu64;
#define RLX_AGENT __ATOMIC_RELAXED, __HIP_MEMORY_SCOPE_AGENT
#define LDS_WAIT() asm volatile("s_waitcnt lgkmcnt(0)" ::: "memory")
#define VM_WAIT() asm volatile("s_waitcnt vmcnt(0)" ::: "memory")
__device__ __forceinline__ unsigned f2bf(float f) { unsigned u = __builtin_bit_cast(unsigned, f); return (u + 0x7fffu + ((u >> 16) & 1u)) >> 16; }
__device__ __forceinline__ unsigned pk2(float lo, float hi) { return f2bf(lo) | (f2bf(hi) << 16); }

#define XB_TMO      128
#define XB_XCNT(j)  (256  + 64 * (j))
#define XB_XSUB(j)  (1280 + 64 * (j))
#define XB_XGEN(j)  (2304 + 64 * (j))
#define XB_TOP      3328
#define XB_TOPGEN   3392
#define XCD_BAR_WORDS 3456
#define XB_SPIN_CAP (1u << 18)

__device__ __forceinline__ unsigned xb_ld(unsigned* p)              { return __hip_atomic_load(p, __ATOMIC_RELAXED, __HIP_MEMORY_SCOPE_AGENT); }
__device__ __forceinline__ unsigned xb_add(unsigned* p, unsigned v) { return __hip_atomic_fetch_add(p, v, __ATOMIC_RELAXED, __HIP_MEMORY_SCOPE_AGENT); }
__device__ __forceinline__ unsigned xb_xcc_id() { return (unsigned)__builtin_amdgcn_s_getreg((3 << 11) | 20) & 0xFu; }
#define XB_SPIN(cond, bar) do { unsigned _sp = 0; while (cond) { __builtin_amdgcn_s_sleep(1); \
    if ((++_sp & 255u) == 0u) { if (xb_ld(&(bar)[XB_TMO])) break; if (_sp > XB_SPIN_CAP) { atomicAdd(&(bar)[XB_TMO], 1u); break; } } } } while (0)

struct XcdBarrier {
    unsigned* bar; unsigned x;
    volatile LAS unsigned* st;
};

__device__ __forceinline__ XcdBarrier xcd_barrier_post(unsigned* bar, volatile LAS unsigned* st) {
    XcdBarrier b; b.bar = bar; b.x = xb_xcc_id(); b.st = st;
    if (threadIdx.x == 0) (void)xb_add(&bar[XB_XCNT(b.x)], 1u);
    return b;
}
__device__ __forceinline__ void xcd_barrier_complete(unsigned* bar, unsigned x, unsigned& nloc, unsigned& nx) {
    const unsigned G = gridDim.x * gridDim.y * gridDim.z;
    unsigned sum, cnt, mine, sp = 0u;
    for (;;) {
        sum = 0u; cnt = 0u; mine = 0u;
#pragma unroll
        for (unsigned j = 0; j < 16; ++j) { const unsigned c = xb_ld(&bar[XB_XCNT(j)]); sum += c; cnt += (c > 0u) ? 1u : 0u; mine = (j == x) ? c : mine; }
        if (sum == G) break;
        __builtin_amdgcn_s_sleep(1);
        if ((++sp & 255u) == 0u) { if (xb_ld(&bar[XB_TMO])) break; if (sp > XB_SPIN_CAP) { atomicAdd(&bar[XB_TMO], 1u); break; } }
    }
    nloc = mine > 0u ? mine : 1u; nx = cnt > 0u ? cnt : 1u;
}

__device__ __forceinline__ void xcd_barrier(const XcdBarrier& b) {
    asm volatile("s_waitcnt vmcnt(0)" ::: "memory");
    __syncthreads();
    if (threadIdx.x == 0) {
        unsigned* bar = b.bar;
        __builtin_amdgcn_s_waitcnt(0);
        unsigned nloc = b.st[0], nx = b.st[1];
        if (nloc == 0u) { xcd_barrier_complete(bar, b.x, nloc, nx); b.st[0] = nloc; b.st[1] = nx; }
        const unsigned old = xb_add(&bar[XB_XSUB(b.x)], 1u);
        const unsigned gen = old / nloc;
        if (old + 1u == (gen + 1u) * nloc) {
            __builtin_amdgcn_fence(__ATOMIC_RELEASE, "agent");
            asm volatile("s_waitcnt vmcnt(0)" ::: "memory");
            const unsigned og = xb_add(&bar[XB_TOP], 1u);
            const unsigned tg = og / nx;
            if (og + 1u == (tg + 1u) * nx) xb_add(&bar[XB_TOPGEN], 1u);
            else XB_SPIN(xb_ld(&bar[XB_TOPGEN]) == tg, bar);
            __builtin_amdgcn_fence(__ATOMIC_ACQUIRE, "agent");
            xb_add(&bar[XB_XGEN(b.x)], 1u);
            asm volatile("s_waitcnt vmcnt(0)" ::: "memory");
        } else {
            XB_SPIN(xb_ld(&bar[XB_XGEN(b.x)]) == gen, bar);
            __builtin_amdgcn_fence(__ATOMIC_ACQUIRE, "agent");
            asm volatile("s_waitcnt vmcnt(0)" ::: "memory");
        }
    }
    __syncthreads();
}

struct Frame {
    LAS unsigned char* lds;
    volatile LAS unsigned* MISC;
    gu32* ctl;
    int tid, lane, wave;
    int vcu, G;
    const float *x, *w_in, *sinks, *lbl, *hg, *wba, *wbh, *wout, *g_mix, *g_moe, *w_rg, *b_rg, *w_re, *b_re, *w1, *w3, *w2, *g_fin;
    float* out;
    unsigned char* ws;
};
#define LDS_WAIT_() asm volatile("s_waitcnt lgkmcnt(0)" ::: "memory")
__device__ __forceinline__ void p0_transpose_item(const float* W, int K, int N, bf16* WT, int kb, int nb, int row_off, LAS float* scr, int lane, int ldk = 0, int koff = 0, const float* kscale = nullptr, float f8scale = 0.f) {
    if (ldk == 0) ldk = K;
    const int k0 = 64 * kb, n0 = 32 * nb;
    { float t_[32];
      const float* wp = W + (size_t)(k0 + (lane >> 5)) * N + n0 + (lane & 31);
#pragma unroll
      for (int i = 0; i < 32; ++i) t_[i] = wp[(size_t)(2 * i) * N];
#pragma unroll
      for (int i = 0; i < 32; ++i) scr[(2 * i + (lane >> 5)) * 33 + (lane & 31)] = t_[i]; }
    LDS_WAIT(); asm volatile("" ::: "memory");
    const int c = lane & 7;
    f32x4 s0 = (f32x4){1.f, 1.f, 1.f, 1.f}, s1 = s0;
    if (kscale) { s0 = *(const f32x4*)(kscale + k0 + 8 * c); s1 = *(const f32x4*)(kscale + k0 + 8 * c + 4); }
    if (f8scale != 0.f) { s0 *= f8scale; s1 *= f8scale; }
#pragma unroll
    for (int j = 0; j < 4; ++j) { const int n = (lane >> 3) + 8 * j; const LAS float* s = scr + (8 * c) * 33 + n;
        if (f8scale != 0.f) {
            int lo = __builtin_amdgcn_cvt_pk_fp8_f32(s[0 * 33] * s0.x, s[1 * 33] * s0.y, 0, false); lo = __builtin_amdgcn_cvt_pk_fp8_f32(s[2 * 33] * s0.z, s[3 * 33] * s0.w, lo, true);
            int hi = __builtin_amdgcn_cvt_pk_fp8_f32(s[4 * 33] * s1.x, s[5 * 33] * s1.y, 0, false); hi = __builtin_amdgcn_cvt_pk_fp8_f32(s[6 * 33] * s1.z, s[7 * 33] * s1.w, hi, true);
            *(GAS unsigned long long*)((unsigned char*)WT + (size_t)(row_off + n0 + n) * ldk + koff + k0 + 8 * c) = (unsigned long long)(unsigned)lo | ((unsigned long long)(unsigned)hi << 32);
            continue; }
        v4u o; o.x = pk2(s[0 * 33] * s0.x, s[1 * 33] * s0.y); o.y = pk2(s[2 * 33] * s0.z, s[3 * 33] * s0.w); o.z = pk2(s[4 * 33] * s1.x, s[5 * 33] * s1.y); o.w = pk2(s[6 * 33] * s1.z, s[7 * 33] * s1.w);
        *(GAS v4u*)(WT + (size_t)(row_off + n0 + n) * ldk + koff + k0 + 8 * c) = o; }
    LDS_WAIT(); asm volatile("" ::: "memory");
}
__device__ __forceinline__ void moe_weight_item(Frame& F, int r) {
    LAS float* scr = (LAS float*)(F.lds + RING_OFF + F.wave * 16384);
    bf16* W13T = (bf16*)(F.ws + WS_W13); bf16* W2T = (bf16*)(F.ws + WS_W2);
    constexpr int I_E = 512 * NEXP;
    if (r < 2 * I_E) {
        const int is3 = r >= I_E; if (is3) r -= I_E;
        const int e = r / 512, q = r % 512, kb = q / 16, nb = q % 16, n0 = 32 * nb;
        const int row_off = e * 1024 + 256 * (n0 >> 7) + (n0 & 127) + (is3 ? 128 : 0) - n0;
        p0_transpose_item((is3 ? F.w3 : F.w1) + (size_t)e * DM * DEXP, DM, DEXP, W13T, kb, nb, row_off, scr, F.lane, 0, 0, F.g_moe, 64.f);
    } else if (r >= 3 * I_E) {
        r -= 3 * I_E;
        bf16* WbaT = (bf16*)(F.ws + WS_WBA); bf16* WoutT = (bf16*)(F.ws + WS_WOUT);
        if (r < 1024) p0_transpose_item(F.wba, 1024, DM, WbaT, r / 64, r % 64, 0, scr, F.lane, DM, 0);
        else if (r < 2048) { r -= 1024; p0_transpose_item(F.wbh, 1024, DM, WbaT, r / 64, r % 64, 0, scr, F.lane, DM, 1024); }
        else { r -= 2048; p0_transpose_item(F.wout, DM, DM, WoutT, r / 64, r % 64, 0, scr, F.lane, 0, 0, nullptr, P4_F8 ? 64.f : 0.f); }
    } else {
        r -= 2 * I_E;
        const int e = r / 512, q = r % 512, kb = q / 64, nb = q % 64;
        p0_transpose_item(F.w2 + (size_t)e * DEXP * DM, DEXP, DM, (bf16*)((unsigned char*)W2T + (size_t)e * DM * DEXP), kb, nb, 0, scr, F.lane, 0, 0, nullptr, 32.f);
    }
}
#if !MK_NAIVE_MIX
namespace mix {
using pg8::cvt_pk_bf16; using pg8::LOG2E;
typedef unsigned u32x2 __attribute__((ext_vector_type(2)));
typedef short v4i16_t __attribute__((ext_vector_type(4)));
__device__ __forceinline__ float bf2f(bf16 h) { return __uint_as_float((unsigned)h << 16); }
__device__ __forceinline__ bf16x8 mk8(unsigned a, unsigned b, unsigned c, unsigned d) { v4u w; w.x = a; w.y = b; w.z = c; w.w = d; return __builtin_bit_cast(bf16x8, w); }
__device__ __forceinline__ bf16x4 vtr(const LAS unsigned char* p) { return __builtin_bit_cast(bf16x4, __builtin_amdgcn_ds_read_tr16_b64_v4i16((LAS v4i16_t*)p)); }
__device__ __forceinline__ int crow(int r, int h) { return (r & 3) + 8 * (r >> 2) + 4 * h; }
template <int CTRL> __device__ __forceinline__ float dpp_f(float x) { return __builtin_bit_cast(float, __builtin_amdgcn_update_dpp(0, __builtin_bit_cast(int, x), CTRL, 0xF, 0xF, true)); }
__device__ __forceinline__ float row16_sum(float x) { x += dpp_f<0xB1>(x); x += dpp_f<0x4E>(x); x += dpp_f<0x124>(x); x += dpp_f<0x128>(x); return x; }

constexpr int KP = 144;
constexpr int ATT_K = 0, ATT_V = 256 * KP;
__device__ __forceinline__ void attn_unit(Frame& F, int b, int n, int hkv) {
    const bf16* QA = (const bf16*)(F.ws + WS_QA); const bf16* KA = (const bf16*)(F.ws + WS_KA); const bf16* VA = (const bf16*)(F.ws + WS_VA); bf16* OA = (bf16*)F.out;
    LAS unsigned char* Kb = F.lds + RING_OFF + ATT_K; LAS unsigned char* Vb = F.lds + RING_OFF + ATT_V;
    const int lane = F.lane, l31 = lane & 31, h = lane >> 5;
    const size_t blk0 = (size_t)b * SEQ + (size_t)n * 128;
    {
        const int j0 = (n == 0) ? 128 : 0;
        v4u kv[4], vv[4];
#pragma unroll
        for (int i = 0; i < 4; ++i) { const int c = F.tid + 512 * i, row = c >> 3, part = c & 7, rowc = row < j0 ? j0 : row;
            const size_t g = (blk0 - 128 + rowc) * 256 + hkv * 64 + part * 8; kv[i] = *(const v4u*)(KA + g); vv[i] = *(const v4u*)(VA + g); }
#pragma unroll
        for (int i = 0; i < 4; ++i) { const int c = F.tid + 512 * i, row = c >> 3, part = c & 7;
            *(LAS v4u*)(Kb + row * KP + part * 16) = kv[i]; *(LAS v4u*)(Vb + row * KP + part * 16) = vv[i]; }
    }
    __syncthreads();
    const int g = F.wave >> 1;
    const int hq = hkv * 4 + g; const float sink2 = F.sinks[hq] * LOG2E;
#pragma unroll 1
    for (int rr = 0; rr < 2; ++rr) {
        const int rblk = (F.wave & 1) * 2 + rr;
        const size_t qrow = blk0 + 32 * rblk + l31;
        bf16x8 qf[4];
#pragma unroll
        for (int s = 0; s < 4; ++s) qf[s] = *(const bf16x8*)(QA + qrow * 1024 + hq * 64 + 16 * s + 8 * h);
        f32x16 sc[5];
#pragma unroll
        for (int i = 0; i < 5; ++i) {
            const int jt = rblk + i;
            f32x16 acc;
#pragma unroll
            for (int r = 0; r < 16; ++r) acc[r] = 0.f;
            if (n > 0 || jt >= 4) {
#pragma unroll
                for (int s = 0; s < 4; ++s) { const bf16x8 a = *(const LAS bf16x8*)(Kb + (32 * jt + l31) * KP + (16 * s + 8 * h) * 2);
                    acc = __builtin_amdgcn_mfma_f32_32x32x16_bf16(a, qf[s], acc, 0, 0, 0); }
#pragma unroll
                for (int r = 0; r < 16; ++r) { const int c = crow(r, h);
                    if (i == 0) acc[r] = (c > l31) ? acc[r] : -1.0e30f;
                    if (i == 4) acc[r] = (c <= l31) ? acc[r] : -1.0e30f; }
            } else {
#pragma unroll
                for (int r = 0; r < 16; ++r) acc[r] = -1.0e30f;
            }
            sc[i] = acc;
        }
        float m = sink2;
#pragma unroll
        for (int i = 0; i < 5; ++i)
#pragma unroll
            for (int r = 0; r < 16; ++r) m = fmaxf(m, sc[i][r]);
        m = fmaxf(m, __shfl_xor(m, 32));
        float l = 0.f;
#pragma unroll
        for (int i = 0; i < 5; ++i)
#pragma unroll
            for (int r = 0; r < 16; ++r) { const float p = __builtin_amdgcn_exp2f(sc[i][r] - m); sc[i][r] = p; l += p; }
        l += __shfl_xor(l, 32);
        l += __builtin_amdgcn_exp2f(sink2 - m);
        const float inv = 1.0f / l;
        f32x16 o[2];
#pragma unroll
        for (int r = 0; r < 16; ++r) { o[0][r] = 0.f; o[1][r] = 0.f; }
        const int i16 = lane & 15, tq = i16 >> 2, tp = i16 & 3, g16 = (lane >> 4) & 1;
#pragma unroll
        for (int i = 0; i < 5; ++i) {
            const int jt = rblk + i;
            if (n > 0 || jt >= 4) {
#pragma unroll
                for (int s = 0; s < 2; ++s) {
                    const bf16x8 pa = mk8(cvt_pk_bf16(sc[i][8 * s] * inv, sc[i][8 * s + 1] * inv), cvt_pk_bf16(sc[i][8 * s + 2] * inv, sc[i][8 * s + 3] * inv),
                                          cvt_pk_bf16(sc[i][8 * s + 4] * inv, sc[i][8 * s + 5] * inv), cvt_pk_bf16(sc[i][8 * s + 6] * inv, sc[i][8 * s + 7] * inv));
#pragma unroll
                    for (int dn = 0; dn < 2; ++dn) {
                        const LAS unsigned char* vp = Vb + (32 * jt + 16 * s + 4 * h + tq) * KP + (dn * 32 + 16 * g16 + 4 * tp) * 2;
                        const bf16x4 lo = vtr(vp), hi = vtr(vp + 8 * KP);
                        const bf16x8 vb = __builtin_shufflevector(lo, hi, 0, 1, 2, 3, 4, 5, 6, 7);
                        o[dn] = __builtin_amdgcn_mfma_f32_32x32x16_bf16(pa, vb, o[dn], 0, 0, 0);
                    }
                }
            }
        }
#pragma unroll
        for (int dn = 0; dn < 2; ++dn)
#pragma unroll
            for (int r = 0; r < 16; ++r) OA[(blk0 + 32 * rblk + crow(r, h)) * 2048 + hq * 64 + dn * 32 + l31] = (bf16)(cvt_pk_bf16(o[dn][r], 0.f) & 0xffffu);
    }
    __syncthreads();
}

constexpr int QP = 272, AP = 80, TILE = 32 * QP;
constexpr int HRAW = 0, HQT = 8 * TILE, HKT = HQT + TILE, HKH = HKT + TILE, HDD = HKH + 8192, HAM = HDD + 512, HSS = HAM + 32 * AP, HOT = HSS + 1024;
static_assert(HOT + TILE <= RING_BYTES, "HGRN LDS map");
#define LBAR() do { asm volatile("s_waitcnt lgkmcnt(0)" ::: "memory"); __builtin_amdgcn_s_barrier(); asm volatile("" ::: "memory"); } while (0)
constexpr int PRAW = 0, PKT = 6 * TILE, PAM = PKT + TILE, POUT = PAM + 32 * AP;
static_assert(POUT + 6 * TILE <= RING_BYTES, "HGRN prep LDS map");
__device__ __forceinline__ void hgrn_prep_unit(Frame& F, int b, int h, int cg, int dummy = 0) {
    const bf16* QHp = (const bf16*)(F.ws + WS_QH); const bf16* LFp = (const bf16*)(F.ws + WS_LF); const bf16* IHp = (const bf16*)(F.ws + WS_IH);
    bf16* QHo = dummy ? (bf16*)(F.ws + 555 * MiB) : (bf16*)(F.ws + WS_QH); bf16* LFo = dummy ? (bf16*)(F.ws + 587 * MiB) : (bf16*)(F.ws + WS_LF);
    bf16* OI = dummy ? (bf16*)(F.ws + 555 * MiB) : (bf16*)((unsigned char*)F.out + 64 * MiB); float* DD = dummy ? (float*)((unsigned char*)F.out + 98 * MiB) : (float*)((unsigned char*)F.out + 96 * MiB);
    LAS unsigned char* L = F.lds + RING_OFF;
    const int lane = F.lane, w = F.wave, fr = lane & 15, q = lane >> 4, tq = fr >> 2, tp = fr & 3;
    const int kcol = 16 * w + fr, cb = h * 128;
    const int lrow = F.tid >> 4, lpart = F.tid & 15;
    const int trc = (16 * w + 4 * tp) * 2;
    bf16x8 LA[2];
#pragma unroll
    for (int mt = 0; mt < 2; ++mt) { bf16x8 a;
#pragma unroll
        for (int j = 0; j < 8; ++j) a[j] = (8 * q + j <= 16 * mt + fr) ? (short)0x3F80 : (short)0;
        LA[mt] = a; }
    if (F.tid < 128) { const int t = F.tid >> 3, c = F.tid & 7; *(LAS unsigned*)(L + PAM + t * AP + 32 + c * 4) = 0u; }
    v4u pre[3];
    const int c0 = 8 * cg;
#define HP_LOAD(c_) do { const size_t o_ = ((size_t)b * SEQ + 32 * (c_) + lrow) * 1024 + cb + lpart * 8; pre[0] = *(const v4u*)(QHp + o_); pre[1] = *(const v4u*)(LFp + o_); pre[2] = *(const v4u*)(IHp + o_); } while (0)
#define HP_PUT(buf_) do { _Pragma("unroll") for (int a_ = 0; a_ < 3; ++a_) *(LAS v4u*)(L + PRAW + ((buf_) * 3 + a_) * TILE + lrow * QP + lpart * 16) = pre[a_]; } while (0)
    HP_LOAD(c0); HP_PUT(0);
    __syncthreads();
    HP_LOAD(c0 + 1);
#pragma unroll 1
    for (int i = 0; i < 8; ++i) {
        const int c = c0 + i;
        const size_t row0 = (size_t)b * SEQ + 32 * c;
        const LAS unsigned char* R = L + PRAW + (i & 1) * 3 * TILE;
        LAS unsigned char* O = L + POUT + (i & 1) * 3 * TILE;
        f32x4 bacc[2]; bf16x4 q4[2], l4[2];
        { const LAS unsigned char* p = R + TILE + (8 * q + tq) * QP + trc;
          const bf16x4 lo = vtr(p), hi = vtr(p + 4 * QP);
#pragma unroll
          for (int mt = 0; mt < 2; ++mt) { const LAS unsigned char* po = R + (16 * mt + 4 * q + tq) * QP + trc; q4[mt] = vtr(po); l4[mt] = vtr(po + TILE); }
          const bf16x8 lb = __builtin_shufflevector(lo, hi, 0, 1, 2, 3, 4, 5, 6, 7);
#pragma unroll
          for (int mt = 0; mt < 2; ++mt) bacc[mt] = __builtin_amdgcn_mfma_f32_16x16x32_bf16(LA[mt], lb, (f32x4){0.f, 0.f, 0.f, 0.f}, 0, 0, 0); }
        const float blast = __shfl(bacc[1][3], 48 + fr);
#pragma unroll
        for (int mt = 0; mt < 2; ++mt)
#pragma unroll
            for (int r = 0; r < 4; ++r) { const float bb = bacc[mt][r], lf = bf2f((bf16)l4[mt][r]), qv = bf2f((bf16)q4[mt][r]);
                const float kk = 1.0f - __builtin_amdgcn_exp2f(lf * LOG2E), eb = __builtin_amdgcn_exp2f(bb * LOG2E);
                const int t = 16 * mt + 4 * q + r;
                *(LAS unsigned short*)(O + t * QP + kcol * 2) = (unsigned short)(cvt_pk_bf16(qv * eb, 0.f) & 0xffffu);
                *(LAS unsigned short*)(L + PKT + t * QP + kcol * 2) = (unsigned short)(cvt_pk_bf16(kk * __builtin_amdgcn_exp2f(fminf(-bb * LOG2E, 120.f)), 0.f) & 0xffffu);
                *(LAS unsigned short*)(O + TILE + t * QP + kcol * 2) = (unsigned short)(cvt_pk_bf16(kk * __builtin_amdgcn_exp2f((blast - bb) * LOG2E), 0.f) & 0xffffu); }
        DD[((size_t)b * (SEQ / 32) + c) * 1024 + cb + kcol] = __builtin_amdgcn_exp2f(blast * LOG2E);
        LBAR();
        if (w < 3) {
            const int ti = (w + 1) >> 1, si = w >> 1;
            f32x4 am = (f32x4){0.f, 0.f, 0.f, 0.f};
            bf16x8 ka[4], qa[4];
#pragma unroll
            for (int Tk = 0; Tk < 4; ++Tk) { ka[Tk] = *(const LAS bf16x8*)(L + PKT + (16 * si + fr) * QP + (32 * Tk + 8 * q) * 2); qa[Tk] = *(const LAS bf16x8*)(O + (16 * ti + fr) * QP + (32 * Tk + 8 * q) * 2); }
#pragma unroll
            for (int Tk = 0; Tk < 4; ++Tk) am = __builtin_amdgcn_mfma_f32_16x16x32_bf16(ka[Tk], qa[Tk], am, 0, 0, 0);
            const int t = 16 * ti + fr;
#pragma unroll
            for (int r = 0; r < 4; ++r) am[r] = (16 * si + 4 * q + r <= t) ? am[r] : 0.f;
            u32x2 aw; aw.x = cvt_pk_bf16(am[0], am[1]); aw.y = cvt_pk_bf16(am[2], am[3]);
            *(LAS u32x2*)(L + PAM + t * AP + (16 * si + 4 * q) * 2) = aw;
        }
        LBAR();
        { const LAS unsigned char* p = R + 2 * TILE + (8 * q + tq) * QP + trc; const bf16x4 lo = vtr(p), hi = vtr(p + 4 * QP);
          const bf16x8 vfrag = __builtin_shufflevector(lo, hi, 0, 1, 2, 3, 4, 5, 6, 7);
          bf16x8 amf[2];
#pragma unroll
          for (int mt = 0; mt < 2; ++mt) amf[mt] = *(const LAS bf16x8*)(L + PAM + (16 * mt + fr) * AP + q * 16);
#pragma unroll
          for (int mt = 0; mt < 2; ++mt) { const f32x4 oi = __builtin_amdgcn_mfma_f32_16x16x32_bf16(amf[mt], vfrag, (f32x4){0.f, 0.f, 0.f, 0.f}, 0, 0, 0);
#pragma unroll
              for (int r = 0; r < 4; ++r) *(LAS unsigned short*)(O + 2 * TILE + (16 * mt + 4 * q + r) * QP + kcol * 2) = (unsigned short)(cvt_pk_bf16(oi[r], 0.f) & 0xffffu); } }
        HP_PUT((i + 1) & 1);
        LBAR();
        HP_LOAD((i + 2 < 8 ? c + 2 : c0 + 7));
        { const size_t go = (row0 + lrow) * 1024 + cb + lpart * 8; const LAS unsigned char* op = O + lrow * QP + lpart * 16;
          *(v4u*)(QHo + go) = *(const LAS v4u*)op; *(v4u*)(LFo + go) = *(const LAS v4u*)(op + TILE); *(v4u*)(OI + go) = *(const LAS v4u*)(op + 2 * TILE); }
    }
#undef HP_LOAD
#undef HP_PUT
    __syncthreads();
}
constexpr int SRAW = 0, SDD = 10 * TILE, SSS = SDD + 1024, SOT = SSS + 2048;
static_assert(SOT + 2 * TILE <= RING_BYTES, "HGRN scan LDS map");
template <int VAR = 0> __device__ __forceinline__ void hgrn_seq_unit(Frame& F, int b, int h, int dummy = 0) {
    const bf16* SRC[5] = {(const bf16*)(F.ws + WS_QH), (const bf16*)(F.ws + WS_LF), (const bf16*)(F.ws + WS_IH), (const bf16*)((const unsigned char*)F.out + 64 * MiB), (const bf16*)(F.ws + WS_SOG)};
    const float* DD = (const float*)((const unsigned char*)F.out + 96 * MiB);
    bf16* OH = dummy ? (bf16*)(F.ws + 251 * MiB) : (bf16*)F.out + 1024;
    LAS unsigned char* L = F.lds + RING_OFF;
    const int lane = F.lane, w = F.wave, fr = lane & 15, q = lane >> 4, tq = fr >> 2, tp = fr & 3;
    const int kcol = 16 * w + fr, cb = h * 128;
    const int lrow = F.tid >> 4, lpart = F.tid & 15;
    const int trc = (16 * w + 4 * tp) * 2;
    float gv[8];
#pragma unroll
    for (int i = 0; i < 8; ++i) gv[i] = F.hg[8 * lpart + i];
    f32x4 S[8];
#pragma unroll
    for (int T = 0; T < 8; ++T) S[T] = (f32x4){0.f, 0.f, 0.f, 0.f};
    v4u preA[5], preB[5]; f32x4 predA = (f32x4){0.f, 0.f, 0.f, 0.f}, predB = predA;
#define HS_LOAD(c_, pre, pred) do { const size_t o_ = ((size_t)b * SEQ + 32 * (c_) + lrow) * 1024 + cb + lpart * 8; \
        _Pragma("unroll") for (int a_ = 0; a_ < 5; ++a_) pre[a_] = *(const v4u*)(SRC[a_] + o_); \
        pred = *(const f32x4*)(DD + ((size_t)b * (SEQ / 32) + (c_)) * 1024 + cb + 4 * (F.tid & 31)); } while (0)
#define HS_PUT(buf_, pre, pred) do { _Pragma("unroll") for (int a_ = 0; a_ < 4; ++a_) *(LAS v4u*)(L + SRAW + ((buf_) * 5 + a_) * TILE + lrow * QP + lpart * 16) = pre[a_]; \
        if (F.tid < 32) *(LAS f32x4*)(L + SDD + (buf_) * 512 + 16 * F.tid) = pred; } while (0)
    HS_LOAD(0, preA, predA); HS_PUT(0, preA, predA);
    v4u sgA = preA[4], sgB = preA[4];
    __syncthreads();
    HS_LOAD(1, preA, predA); HS_LOAD(2, preB, predB);
#define HS_NORM_STORE(p_, sg_, row_) do { const v4u ov_ = *(const LAS v4u*)(L + SOT + (p_) * TILE + lrow * QP + lpart * 16); float v_[8], g_[8]; pg8::unpack8(ov_, v_); pg8::unpack8(sg_, g_); \
        float ss_ = (v_[0] * v_[0] + v_[1] * v_[1]) + (v_[2] * v_[2] + v_[3] * v_[3]) + (v_[4] * v_[4] + v_[5] * v_[5]) + (v_[6] * v_[6] + v_[7] * v_[7]); ss_ = row16_sum(ss_); \
        const float rs_ = __builtin_amdgcn_rsqf(ss_ * (1.f / 128.f) + EPS); \
        v4u w_; w_.x = cvt_pk_bf16(v_[0] * rs_ * gv[0] * g_[0], v_[1] * rs_ * gv[1] * g_[1]); w_.y = cvt_pk_bf16(v_[2] * rs_ * gv[2] * g_[2], v_[3] * rs_ * gv[3] * g_[3]); \
        w_.z = cvt_pk_bf16(v_[4] * rs_ * gv[4] * g_[4], v_[5] * rs_ * gv[5] * g_[5]); w_.w = cvt_pk_bf16(v_[6] * rs_ * gv[6] * g_[6], v_[7] * rs_ * gv[7] * g_[7]); \
        *(v4u*)(OH + ((row_) + lrow) * 2048 + cb + lpart * 8) = w_; } while (0)
#define HS_STEP(c, pre, pred) { \
        const int par = c & 1; \
        const size_t row0 = (size_t)b * SEQ + 32 * c; \
        const LAS unsigned char* R = L + SRAW + par * 5 * TILE; \
        bf16x8 sb[4]; \
        _Pragma("unroll") \
        for (int Tk = 0; Tk < 4; ++Tk) sb[Tk] = mk8(cvt_pk_bf16(S[2 * Tk][0], S[2 * Tk][1]), cvt_pk_bf16(S[2 * Tk][2], S[2 * Tk][3]), cvt_pk_bf16(S[2 * Tk + 1][0], S[2 * Tk + 1][1]), cvt_pk_bf16(S[2 * Tk + 1][2], S[2 * Tk + 1][3])); \
        bf16x8 vfrag, qpf[2][4], khf[8]; f32x4 ddf[8]; bf16x4 oi4[2]; \
        { const LAS unsigned char* p = R + 2 * TILE + (8 * q + tq) * QP + trc; const bf16x4 lo = vtr(p), hi = vtr(p + 4 * QP); vfrag = __builtin_shufflevector(lo, hi, 0, 1, 2, 3, 4, 5, 6, 7); } \
        _Pragma("unroll") \
        for (int mt = 0; mt < 2; ++mt) { \
        _Pragma("unroll") \
            for (int Tk = 0; Tk < 4; ++Tk) { const LAS unsigned char* qp = R + (16 * mt + fr) * QP + (32 * Tk + 4 * q) * 2; \
                const bf16x4 lo = *(const LAS bf16x4*)qp, hi = *(const LAS bf16x4*)(qp + 32); qpf[mt][Tk] = __builtin_shufflevector(lo, hi, 0, 1, 2, 3, 4, 5, 6, 7); } \
            const LAS unsigned char* po = R + 3 * TILE + (16 * mt + 4 * q + tq) * QP + trc; oi4[mt] = vtr(po); } \
        _Pragma("unroll") \
        for (int T = 0; T < 8; ++T) { ddf[T] = *(const LAS f32x4*)(L + SDD + par * 512 + (16 * T + 4 * q) * 4); \
            const LAS unsigned char* kp = R + TILE + (8 * q + tq) * QP + (16 * T + 4 * tp) * 2; const bf16x4 lo = vtr(kp), hi = vtr(kp + 4 * QP); khf[T] = __builtin_shufflevector(lo, hi, 0, 1, 2, 3, 4, 5, 6, 7); } \
        f32x4 o[2]; \
        _Pragma("unroll") \
        for (int mt = 0; mt < 2; ++mt) o[mt] = (f32x4){bf2f((bf16)oi4[mt][0]), bf2f((bf16)oi4[mt][1]), bf2f((bf16)oi4[mt][2]), bf2f((bf16)oi4[mt][3])}; \
        _Pragma("unroll") \
        for (int Tk = 0; Tk < 4; ++Tk) \
        _Pragma("unroll") \
            for (int mt = 0; mt < 2; ++mt) { if (VAR < 2) o[mt] = __builtin_amdgcn_mfma_f32_16x16x32_bf16(qpf[mt][Tk], sb[Tk], o[mt], 0, 0, 0); else asm volatile("" :: "v"(qpf[mt][Tk]), "v"(sb[Tk])); } \
        _Pragma("unroll") \
        for (int T = 0; T < 8; ++T) { if (VAR < 2) S[T] = __builtin_amdgcn_mfma_f32_16x16x32_bf16(khf[T], vfrag, S[T] * ddf[T], 0, 0, 0); else { S[T] = S[T] * ddf[T]; asm volatile("" :: "v"(khf[T]), "v"(vfrag)); } } \
        HS_PUT(par ^ 1, pre, pred); \
        LBAR(); \
        if (c > 0 && VAR != 1 && VAR != 3) HS_NORM_STORE(par ^ 1, sgA, row0 - 32); \
        _Pragma("unroll") \
        for (int mt = 0; mt < 2; ++mt) \
        _Pragma("unroll") \
            for (int r = 0; r < 4; ++r) *(LAS unsigned short*)(L + SOT + par * TILE + (16 * mt + 4 * q + r) * QP + kcol * 2) = (unsigned short)(cvt_pk_bf16(o[mt][r], 0.f) & 0xffffu); \
        sgA = sgB; sgB = pre[4]; \
        HS_LOAD((c + 3 < SEQ / 32 ? c + 3 : SEQ / 32 - 1), pre, pred); }
#pragma unroll 1
    for (int c2 = 0; c2 < SEQ / 32; c2 += 2) { HS_STEP((c2), preA, predA) HS_STEP((c2 + 1), preB, predB) }
#undef HS_STEP
#undef HS_LOAD
#undef HS_PUT
    __syncthreads();
    HS_NORM_STORE(1, sgA, (size_t)b * SEQ + SEQ - 32);
    __syncthreads();
}
#undef HS_NORM_STORE

__device__ __forceinline__ void p2a_mixers(Frame& F, int wq, int dummy = 0, int mask = 3) {
    LAS int* slot = (LAS int*)(F.lds + X_NTILE + 64);
    for (;;) {
        __syncthreads();
        if (F.tid == 0) slot[0] = (int)__hip_atomic_fetch_add(F.ctl + wq, 1u, RLX_AGENT);
        __syncthreads();
        const int u = slot[0];
        if (u >= 1024) break;
        if (u < 512) { if (mask & 1) hgrn_prep_unit(F, u >> 6, (u >> 3) & 7, u & 7, dummy); }
        else if (mask & 2) { const int a = u - 512; attn_unit(F, a >> 6, (a >> 2) & 15, a & 3); }
    }
}
}
constexpr int CONV_U1 = 640, CONV_U2 = 1024;
__device__ __forceinline__ void conv_queue(Frame& F, int wq, int lo, int hi, int maxn = 1 << 30) {
    LAS int* slot = (LAS int*)(F.lds + X_NTILE + 64);
    for (int n_ = 0; n_ < maxn; ++n_) {
        __syncthreads();
        if (F.tid == 0) slot[0] = lo + (int)__hip_atomic_fetch_add(F.ctl + wq, 1u, RLX_AGENT);
        __syncthreads();
        const int u = slot[0];
        if (u >= hi) break;
        const int base = u * 32 + F.wave * 4;
#pragma unroll 1
        for (int k = 0; k < 4; ++k) moe_weight_item(F, base + k);
    }
    __syncthreads();
}
namespace mix {
}
using mix::p2a_mixers;
#endif
__device__ __forceinline__ int lane_id() { return (int)__builtin_amdgcn_mbcnt_hi(~0u, __builtin_amdgcn_mbcnt_lo(~0u, 0u)); }
template <int CTRL> __device__ __forceinline__ float dppf(float x) { return __builtin_bit_cast(float, __builtin_amdgcn_update_dpp(0, __builtin_bit_cast(int, x), CTRL, 0xF, 0xF, true)); }
__device__ __forceinline__ float wave_sum(float v) {
    v += dppf<0xB1>(v); v += dppf<0x4E>(v); v += dppf<0x124>(v); v += dppf<0x128>(v);
    v += __shfl_xor(v, 16); v += __shfl_xor(v, 32);
    return v;
}
__device__ __forceinline__ void p0_prologue(Frame& F, int mask = 7) {
    LAS float* scr = (LAS float*)(F.lds + RING_OFF + F.wave * 16384);
    const int gw = F.vcu * NWAVES + F.wave, NGW = F.G * NWAVES;
    bf16* WinT = (bf16*)(F.ws + WS_WIN); bf16* WbaT = (bf16*)(F.ws + WS_WBA); bf16* WbhT = (bf16*)(F.ws + WS_WBH); bf16* WoutT = (bf16*)(F.ws + WS_WOUT);
    constexpr int I_IN = 32 * 176, I_G8 = 32 * 128, I_BR = 16 * 64, I_OUT = 32 * 64;
    constexpr int NITEMS = I_IN + I_G8 + (P0_ALLW ? 2 * I_BR + I_OUT : 0);
    for (int it = (mask & 1) ? gw : NITEMS; it < NITEMS; it += NGW) {
        int r = it;
        if (r < I_IN) { p0_transpose_item(F.w_in, DM, INW, WinT, r / 176, r % 176, 0, scr, F.lane, LDP1, 0, F.g_mix); continue; } r -= I_IN;
        if (r < I_G8) { p0_transpose_item(F.w_in + 5632, DM, INW, (bf16*)(F.ws + WS_WG8), r / 128, r % 128, 0, scr, F.lane, DM, 0, F.g_mix, 64.f); continue; } r -= I_G8;
        if (r < I_BR) { p0_transpose_item(F.wba, 1024, DM, WbaT, r / 64, r % 64, 0, scr, F.lane, DM, 0); continue; } r -= I_BR;
        if (r < I_BR) { p0_transpose_item(F.wbh, 1024, DM, WbaT, r / 64, r % 64, 0, scr, F.lane, DM, 1024); continue; } r -= I_BR;
        p0_transpose_item(F.wout, DM, DM, WoutT, r / 64, r % 64, 0, scr, F.lane, 0, 0, nullptr, P4_F8 ? 64.f : 0.f);
    }
    bf16* XN = (bf16*)(F.ws + WS_XNB); float* RS0 = (float*)(F.ws + WS_RS0);
    for (int m = (mask & 2) ? gw : TOK; m < TOK; m += NGW) {
        const GAS f32x4* xr = (const GAS f32x4*)(F.x + (size_t)m * DM) + F.lane;
        f32x4 v[8]; float s = 0.f;
#pragma unroll
        for (int j = 0; j < 8; ++j) { v[j] = xr[64 * j]; s += (v[j].x * v[j].x + v[j].y * v[j].y) + (v[j].z * v[j].z + v[j].w * v[j].w); }
        const float ms = wave_sum(s) * (1.f / DM) + EPS;
        const float rstd = __builtin_amdgcn_rsqf(ms);
        if (F.lane == 0) RS0[m] = ms * rstd;
        GAS unsigned long long* o8 = (GAS unsigned long long*)(XN + (size_t)m * LDP1) + F.lane;
        GAS unsigned* o4 = (GAS unsigned*)(F.ws + WS_XN8 + (size_t)m * DM) + F.lane;
#pragma unroll
        for (int j = 0; j < 8; ++j) { const float a0 = v[j].x * rstd, a1 = v[j].y * rstd, a2 = v[j].z * rstd, a3 = v[j].w * rstd;
            o8[64 * j] = (unsigned long long)pk2(a0, a1) | ((unsigned long long)pk2(a2, a3) << 32);
            int q8 = __builtin_amdgcn_cvt_pk_fp8_f32(a0, a1, 0, false); q8 = __builtin_amdgcn_cvt_pk_fp8_f32(a2, a3, q8, true); o4[64 * j] = (unsigned)q8; }
    }
    const int gt = F.vcu * (NWAVES * 64) + F.tid, NGT = F.G * NWAVES * 64;
    float* LB = (float*)(F.ws + WS_LB);
    for (int c = gt; c < 1024; c += NGT) LB[c] = 1.f / (1.f + expf(F.lbl[1024 + c] - F.lbl[c]));
    bf16* WB = (bf16*)(F.ws + WS_WR2);
    for (int id = gt; id < 64 * 3 * 2 * 4 * 16 * 8; id += NGT) {
        const int i = id & 7, col = (id >> 3) & 15, q = (id >> 7) & 3, hl = (id >> 9) & 1, nt = (id >> 10) % 3, j = id / 3072;
        const int k = 32 * j + 8 * q + i, e = 16 * nt + col;
        float w = 0.f; if (e < 32) w = F.w_re[k * 32 + e]; else if (e < 36) w = F.w_rg[k * 4 + (e - 32)];
        w *= F.g_moe[k];
        const unsigned hi = f2bf(w); const float rem = w - __uint_as_float(hi << 16);
        WB[id] = (bf16)(hl ? f2bf(rem) : hi);
    }
}
__device__ __forceinline__ void moe_tables(Frame& F) {
    LAS int* tile_e = (LAS int*)(F.lds + X_TILE_E); LAS int* pstart = (LAS int*)(F.lds + X_PSTART); LAS int* ecnt = (LAS int*)(F.lds + X_ECNT); LAS int* ntile = (LAS int*)(F.lds + X_NTILE);
    __syncthreads();
    if (F.tid < NEXP) { int c = (int)__hip_atomic_load(F.ctl + CW_ECNT + 64 * F.tid, RLX_AGENT); ecnt[F.tid] = c < 0 ? 0 : (c > TOK ? TOK : c); }
    __syncthreads();
    if (F.tid == 0) { int ps = 0, nt = 0;
        for (int e = 0; e < NEXP; ++e) { const int c = ecnt[e]; pstart[e] = ps; const int nte = (c + 255) >> 8; for (int k = 0; k < nte && nt < 160; ++k) tile_e[nt++] = e; ps += nte * 256; }
        pstart[NEXP] = ps; ntile[0] = nt; }
    __syncthreads();
}
__device__ __forceinline__ void p5_router(Frame& F, int cnt_base = CW_ECNT, size_t tokl_off = WS_TOKL) {
    const bf16* H1 = (const bf16*)(F.ws + WS_HN); const bf16* WB = (const bf16*)(F.ws + WS_WR2);
    float* RSTD = (float*)(F.ws + WS_RSTD); int* TOKE = (int*)(F.ws + WS_TOKE); int* TOKP = (int*)(F.ws + WS_TOKP); float* TOKW = (float*)(F.ws + WS_TOKW); int* TOKL = (int*)(F.ws + tokl_off);
    const int w4 = F.wave & 3, half = F.wave >> 2;
    LAS float* lg = (LAS float*)(F.lds + RING_OFF + w4 * 4096);
    LAS float* lgp = (LAS float*)(F.lds + RING_OFF + 16384 + w4 * 4096);
    const int lane = lane_id();
    const int r = lane & 15, kq = lane >> 4;
    for (int rt = F.vcu * 4 + w4; rt < TOK / 16; rt += F.G * 4) {
        const int row = rt * 16 + r;
        const bf16* hrow = H1 + (size_t)row * DM + 8 * kq + 1024 * half;
        f32x4 acc[3]; acc[0] = acc[1] = acc[2] = (f32x4){0.f, 0.f, 0.f, 0.f}; float ss = 0.f;
#pragma unroll 4
        for (int j = 0; j < 32; ++j) {
            const v4u aw = *(const v4u*)(hrow + 32 * j);
            float hf[8]; pg8::unpack8(aw, hf);
            ss += (hf[0] * hf[0] + hf[1] * hf[1]) + (hf[2] * hf[2] + hf[3] * hf[3]) + (hf[4] * hf[4] + hf[5] * hf[5]) + (hf[6] * hf[6] + hf[7] * hf[7]);
            const bf16x8 a = __builtin_bit_cast(bf16x8, aw);
            const bf16* wb = WB + (size_t)(j + 32 * half) * 3072 + (kq * 16 + r) * 8;
#pragma unroll
            for (int nt = 0; nt < 3; ++nt) { const bf16x8 bh = *(const bf16x8*)(wb + nt * 1024), bl = *(const bf16x8*)(wb + nt * 1024 + 512);
                acc[nt] = __builtin_amdgcn_mfma_f32_16x16x32_bf16(a, bh, acc[nt], 0, 0, 0); acc[nt] = __builtin_amdgcn_mfma_f32_16x16x32_bf16(a, bl, acc[nt], 0, 0, 0); }
        }
        if (half == 1) {
#pragma unroll
            for (int nt = 0; nt < 3; ++nt)
#pragma unroll
                for (int i = 0; i < 4; ++i) lgp[lane * 13 + 4 * nt + i] = acc[nt][i];
            lgp[lane * 13 + 12] = ss; }
        __syncthreads();
        if (half == 1) { __syncthreads(); continue; }
#pragma unroll
        for (int nt = 0; nt < 3; ++nt)
#pragma unroll
            for (int i = 0; i < 4; ++i) acc[nt][i] += lgp[lane * 13 + 4 * nt + i];
        ss += lgp[lane * 13 + 12];
        ss += __shfl_xor(ss, 16); ss += __shfl_xor(ss, 32);
        const float rstd = __builtin_amdgcn_rsqf(ss * (1.f / DM) + EPS);
#pragma unroll
        for (int nt = 0; nt < 3; ++nt)
#pragma unroll
            for (int i = 0; i < 4; ++i) lg[(4 * kq + i) * 49 + 16 * nt + r] = acc[nt][i];
        LDS_WAIT(); asm volatile("" ::: "memory");
        if (lane < 16) {
            const LAS float* L = lg + lane * 49;
            float gl[4]; float gmax = -3.0e38f; int grp = 0;
#pragma unroll
            for (int g = 0; g < 4; ++g) { gl[g] = L[32 + g] * rstd + F.b_rg[g]; if (gl[g] > gmax) { gmax = gl[g]; grp = g; } }
            float gs = 0.f;
#pragma unroll
            for (int g = 0; g < 4; ++g) gs += expf(gl[g] - gmax);
            const float psel = 1.0f / gs;
            float el[8]; float m1 = -3.0e38f; int i1 = 0;
#pragma unroll
            for (int i = 0; i < 8; ++i) { el[i] = L[grp * 8 + i] * rstd + F.b_re[grp * 8 + i]; if (el[i] > m1) { m1 = el[i]; i1 = i; } }
            float m2 = -3.0e38f; int i2 = 0;
#pragma unroll
            for (int i = 0; i < 8; ++i) { if (i != i1 && el[i] > m2) { m2 = el[i]; i2 = i; } }
            const float e2 = expf(m2 - m1), inv = 1.0f / (1.0f + e2);
            const int t = rt * 16 + lane, ex0 = grp * 8 + i1, ex1 = grp * 8 + i2;
            const int p0 = (int)__hip_atomic_fetch_add(F.ctl + cnt_base + 64 * ex0, 1u, RLX_AGENT);
            const int p1 = (int)__hip_atomic_fetch_add(F.ctl + cnt_base + 64 * ex1, 1u, RLX_AGENT);
            TOKL[ex0 * TOK + p0] = t; TOKL[ex1 * TOK + p1] = t;
            TOKE[2 * t] = ex0; TOKE[2 * t + 1] = ex1; TOKP[2 * t] = p0; TOKP[2 * t + 1] = p1;
            TOKW[2 * t] = psel * inv; TOKW[2 * t + 1] = psel * e2 * inv; RSTD[t] = rstd;
        }
        __syncthreads();
    }
}
__device__ __forceinline__ void p8_final(Frame& F, bool have_tables = false) {
    if (!have_tables) moe_tables(F);
    const int lane = lane_id();
    const LAS int* pstart = (const LAS int*)(F.lds + X_PSTART);
    const unsigned char* Y = F.ws + WS_Y; const int* TOKE = (const int*)(F.ws + WS_TOKE); const int* TOKP = (const int*)(F.ws + WS_TOKP); const float* TOKW = (const float*)(F.ws + WS_TOKW);
    const int gw = F.vcu * NWAVES + F.wave, NGW = F.G * NWAVES;
    f32x4 gf[8];
#pragma unroll
    for (int j = 0; j < 4; ++j) { gf[2 * j] = *(const f32x4*)(F.g_fin + 512 * j + 8 * lane); gf[2 * j + 1] = *(const f32x4*)(F.g_fin + 512 * j + 8 * lane + 4); }
    int t = gw;
    int e0 = 0, e1 = 0, p0 = 0, p1 = 0; float w0 = 0.f, w1 = 0.f;
    if (t < TOK) { e0 = TOKE[2 * t]; e1 = TOKE[2 * t + 1]; p0 = TOKP[2 * t]; p1 = TOKP[2 * t + 1]; w0 = TOKW[2 * t]; w1 = TOKW[2 * t + 1]; }
    for (; t < TOK; t += NGW) {
        const size_t s0 = (size_t)(pstart[e0 & 31] + p0), s1 = (size_t)(pstart[e1 & 31] + p1);
        const float cw0 = w0 * 0.0625f, cw1 = w1 * 0.0625f;
        float* orow = F.out + (size_t)t * DM + 8 * lane; const bf16* hrow = (const bf16*)(F.ws + WS_HN) + (size_t)t * DM + 8 * lane;
        const unsigned char* y0 = Y + s0 * DM + 8 * lane; const unsigned char* y1 = Y + s1 * DM + 8 * lane;
        v4u hv[4]; unsigned long long ya[4], yb[4];
#pragma unroll
        for (int j = 0; j < 4; ++j) { hv[j] = *(const v4u*)(hrow + 512 * j); ya[j] = *(const unsigned long long*)(y0 + 512 * j); yb[j] = *(const unsigned long long*)(y1 + 512 * j); }
        const int tn = t + NGW;
        if (tn < TOK) { e0 = TOKE[2 * tn]; e1 = TOKE[2 * tn + 1]; p0 = TOKP[2 * tn]; p1 = TOKP[2 * tn + 1]; w0 = TOKW[2 * tn]; w1 = TOKW[2 * tn + 1]; }
        float v[4][8]; float ss = 0.f;
#pragma unroll
        for (int j = 0; j < 4; ++j) { float fa[8], fb[8]; pg8::unpack8_f8(ya[j], fa); pg8::unpack8_f8(yb[j], fb);
            pg8::unpack8(hv[j], v[j]);
#pragma unroll
            for (int i = 0; i < 8; ++i) { v[j][i] += cw0 * fa[i] + cw1 * fb[i]; ss += v[j][i] * v[j][i]; } }
        const float rstd = __builtin_amdgcn_rsqf(wave_sum(ss) * (1.f / DM) + EPS);
#pragma unroll
        for (int j = 0; j < 4; ++j) {
            *(f32x4*)(orow + 512 * j) = (f32x4){v[j][0] * rstd * gf[2 * j].x, v[j][1] * rstd * gf[2 * j].y, v[j][2] * rstd * gf[2 * j].z, v[j][3] * rstd * gf[2 * j].w};
            *(f32x4*)(orow + 512 * j + 4) = (f32x4){v[j][4] * rstd * gf[2 * j + 1].x, v[j][5] * rstd * gf[2 * j + 1].y, v[j][6] * rstd * gf[2 * j + 1].z, v[j][7] * rstd * gf[2 * j + 1].w};
        }
    }
}
#if MK_NAIVE_MIX
__device__ __forceinline__ float bf2f(bf16 h) { return __uint_as_float((unsigned)h << 16); }
__global__ void __launch_bounds__(256) naive_attn(const bf16* QA, const bf16* KA, const bf16* VA, const float* sinks, bf16* OA) {
    const int idx = blockIdx.x * 256 + threadIdx.x, t = idx >> 4, hq = idx & 15, hkv = hq >> 2, pos = t & (SEQ - 1);
    float q[64];
#pragma unroll
    for (int d = 0; d < 64; ++d) q[d] = bf2f(QA[(size_t)t * 1024 + hq * 64 + d]);
    const int lo = pos - 127 < 0 ? 0 : pos - 127;
    const float sink2 = sinks[hq] * pg8::LOG2E; float m = sink2;
    for (int p = lo; p <= pos; ++p) { const bf16* kr = KA + (size_t)(t - pos + p) * 256 + hkv * 64; float s = 0.f;
#pragma unroll
        for (int d = 0; d < 64; ++d) s += q[d] * bf2f(kr[d]);
        m = fmaxf(m, s); }
    float den = exp2f(sink2 - m); float o[64];
#pragma unroll
    for (int d = 0; d < 64; ++d) o[d] = 0.f;
    for (int p = lo; p <= pos; ++p) { const bf16* kr = KA + (size_t)(t - pos + p) * 256 + hkv * 64; const bf16* vr = VA + (size_t)(t - pos + p) * 256 + hkv * 64; float s = 0.f;
#pragma unroll
        for (int d = 0; d < 64; ++d) s += q[d] * bf2f(kr[d]);
        const float w = exp2f(s - m); den += w;
#pragma unroll
        for (int d = 0; d < 64; ++d) o[d] += w * bf2f(vr[d]); }
    const float inv = 1.f / den;
#pragma unroll
    for (int d = 0; d < 64; ++d) OA[(size_t)t * 1024 + hq * 64 + d] = (bf16)f2bf(o[d] * inv);
}
__global__ void __launch_bounds__(128) naive_hgrn(const bf16* QH, const bf16* LF, const bf16* IH, const bf16* SOG, const float* hg, bf16* OH) {
    __shared__ float sf[128], sq[128], red[2];
    const int b = blockIdx.x >> 3, h = blockIdx.x & 7, v = threadIdx.x;
    float S[128];
#pragma unroll
    for (int k = 0; k < 128; ++k) S[k] = 0.f;
    for (int t = 0; t < SEQ; ++t) {
        const size_t row = (size_t)b * SEQ + t;
        sf[v] = expf(bf2f(LF[row * 1024 + h * 128 + v])); sq[v] = bf2f(QH[row * 1024 + h * 128 + v]);
        const float iv = bf2f(IH[row * 1024 + h * 128 + v]);
        __syncthreads();
        float o = 0.f;
#pragma unroll
        for (int k = 0; k < 128; ++k) { const float f = sf[k]; S[k] = f * S[k] + (1.f - f) * iv; o += S[k] * sq[k]; }
        float ss = o * o;
#pragma unroll
        for (int off = 1; off < 64; off <<= 1) ss += __shfl_xor(ss, off);
        if ((v & 63) == 0) red[v >> 6] = ss;
        __syncthreads();
        const float rstd = 1.0f / sqrtf((red[0] + red[1]) * (1.f / 128.f) + EPS);
        OH[row * 1024 + h * 128 + v] = (bf16)f2bf(o * rstd * hg[v] * bf2f(SOG[row * 1024 + h * 128 + v]));
    }
}
#endif

__device__ __forceinline__ void group_census_post(Frame& F) { if (threadIdx.x == 0) (void)xb_add((unsigned*)(F.ctl + CW_GCEN + 16 * (blockIdx.x & 7u) + xb_xcc_id()), 1u); }
__device__ __forceinline__ void group_barrier(Frame& F, int k) {
    asm volatile("s_waitcnt vmcnt(0)" ::: "memory");
    __syncthreads();
    if (threadIdx.x == 0) {
        unsigned* bar = (unsigned*)(F.ctl + CW_BAR);
        const unsigned g = blockIdx.x & 7u, x = xb_xcc_id(), target = (gridDim.x + 7u - g) >> 3;
        const unsigned mine = xb_ld((unsigned*)(F.ctl + CW_GCEN + 16 * g + x));
        unsigned* top = (unsigned*)(F.ctl + CW_GTOP + 64 * (8 * k + g));
        __builtin_amdgcn_s_waitcnt(0);
        const unsigned old = xb_add((unsigned*)(F.ctl + CW_GARR + 128 * k + 16 * g + x), 1u);
        if (old + 1u == mine) {
            __builtin_amdgcn_fence(__ATOMIC_RELEASE, "agent");
            asm volatile("s_waitcnt vmcnt(0)" ::: "memory");
            (void)xb_add(top, mine);
        }
        XB_SPIN(xb_ld(top) < target, bar);
        __builtin_amdgcn_fence(__ATOMIC_ACQUIRE, "agent");
        asm volatile("s_waitcnt vmcnt(0)" ::: "memory");
    }
    __syncthreads();
}
struct Args { const float* in[18]; float* out; unsigned char* ws; int ph_lo, ph_hi; };
__global__ void __launch_bounds__(NWAVES * 64, 2) fwd(Args args) {
    extern __shared__ __attribute__((aligned(16))) unsigned char lds[];
    Frame F;
    F.lds = (LAS unsigned char*)lds;
    F.MISC = (volatile LAS unsigned*)(F.lds + MISC_OFF);
    F.tid = threadIdx.x; F.lane = F.tid & 63; F.wave = __builtin_amdgcn_readfirstlane(F.tid >> 6);
    F.G = gridDim.x; { const int bx = blockIdx.x; F.vcu = (F.G % 8 == 0) ? (bx % 8) * (F.G / 8) + bx / 8 : bx; }
    F.ws = args.ws; F.ctl = (gu32*)(args.ws + WS_CTL); F.out = args.out;
    F.x = args.in[0]; F.w_in = args.in[1]; F.sinks = args.in[2]; F.lbl = args.in[3]; F.hg = args.in[4]; F.wba = args.in[5]; F.wbh = args.in[6]; F.wout = args.in[7];
    F.g_mix = args.in[8]; F.g_moe = args.in[9]; F.w_rg = args.in[10]; F.b_rg = args.in[11]; F.w_re = args.in[12]; F.b_re = args.in[13]; F.w1 = args.in[14]; F.w3 = args.in[15]; F.w2 = args.in[16]; F.g_fin = args.in[17];
    if (F.tid < 16) F.MISC[F.tid] = 0u;
    __syncthreads();
    XcdBarrier bar; bar.bar = (unsigned*)(F.ctl + CW_BAR); bar.x = 0; bar.st = nullptr;
    if (ONE_LAUNCH) bar = xcd_barrier_post((unsigned*)(F.ctl + CW_BAR), F.MISC + 8);
    if (ONE_LAUNCH) group_census_post(F);
#define GRID_BAR() do { if (ONE_LAUNCH) xcd_barrier(bar); } while (0)
    const int lo = args.ph_lo, hi = args.ph_hi;
#define IN(k) (lo <= (k) && (k) < hi)
#define BOTH(k) (IN(k) && IN((k) + 1))
    unsigned char* ws = args.ws;
    bf16* XN = (bf16*)(ws + WS_XNB); bf16* OAH = (bf16*)F.out;

#ifndef DBG_REP
#define DBG_REP -1
#endif
#ifndef DBG_EPI2
#define DBG_EPI2 0
#endif
#ifndef WGM_P1
#define WGM_P1 4
#endif
#ifndef WGM_P1F
#define WGM_P1F 4
#endif
#ifndef WGM_P3A
#define WGM_P3A 2
#endif
#ifndef WGM_P3
#define WGM_P3 2
#endif
#ifndef WGM_P4
#define WGM_P4 2
#endif
#ifndef GROUP_BAR
#define GROUP_BAR 1
#endif
#ifndef P34_STAGGER
#define P34_STAGGER 0
#endif
#ifndef P1_HEAD
#define P1_HEAD 0
#endif
#ifndef P1_SWAP
#define P1_SWAP 2
#endif
    if (IN(0)) { p0_prologue(F); if (DBG_REP == 0) { GRID_BAR(); p0_prologue(F); } if (DBG_REP == 1) { GRID_BAR(); p0_prologue(F, 1); } if (DBG_REP == 9) { GRID_BAR(); p0_prologue(F, 2); } if (BOTH(0)) GRID_BAR(); }

    if (IN(1)) {
        pg8::Gemm g{XN, (const bf16*)(ws + WS_WIN), TOK, 5632, DM, LDP1, LDP1}; pg8::StaticOrder S; S.init(TOK, 5632, F.G, (int)blockIdx.x, WGM_P1);
        pg8::EpiProj E{(bf16*)(ws + WS_QA), (bf16*)(ws + WS_KA), (bf16*)(ws + WS_VA), (bf16*)(ws + WS_QH), (bf16*)(ws + WS_LF), (bf16*)(ws + WS_IH), (bf16*)(ws + WS_SOG), (bf16*)(ws + WS_GATE), (const float*)(ws + WS_LB), 0};
        if (P1_HEAD > 0) conv_queue(F, CW_WQ + 32, 0, CONV_U1, ((int)blockIdx.x >> 6) * P1_HEAD);
        pg8::Gemm g8{(const bf16*)(ws + WS_XN8), (const bf16*)(ws + WS_WG8), 0x79797979, 0x7f7f7f7f, DM, DM, DM};
        pg8::StaticOrder S8; S8.init(TOK, 4096, F.G, (int)blockIdx.x, WGM_P1F);
        pg8::EpiProj E8 = E; E8.pn_off = 22;
        if (P1_SWAP == 2 || (P1_SWAP == 1 && (blockIdx.x & 1))) {
            pg8::gemm_phase_f8<pg8::EpiProj, pg8::StaticOrder, true, false>(F.lds + RING_OFF, g8, S8, E8);
            pg8::gemm_phase<pg8::EpiProj, pg8::StaticOrder, true, false>(F.lds + RING_OFF, g, S, E);
        } else {
            pg8::gemm_phase<pg8::EpiProj, pg8::StaticOrder, true, false, false, (DBG_EPI2 & 1)>(F.lds + RING_OFF, g, S, E);
            pg8::gemm_phase_f8<pg8::EpiProj, pg8::StaticOrder, true, false, false, (DBG_EPI2 & 2)>(F.lds + RING_OFF, g8, S8, E8);
        }
        if (!P0_ALLW) conv_queue(F, CW_WQ + 24, 1536, 1568);
        conv_queue(F, CW_WQ + 32, 0, CONV_U1);
        if (BOTH(1)) GRID_BAR();
    }

    if (IN(2)) {
#if !MK_NAIVE_MIX
        p2a_mixers(F, CW_WQ);
        GRID_BAR();
        if (blockIdx.x < 64) mix::hgrn_seq_unit<0>(F, (int)blockIdx.x >> 3, (int)blockIdx.x & 7);
        else {
            pg8::StaticOrder S; S.init(TOK, DM, F.G - 64, (int)blockIdx.x - 64, WGM_P3A);
            pg8::Gemm g{OAH, (const bf16*)(ws + WS_WBA), TOK, DM, 1024, DM, DM};
            pg8::EpiGate<true> E{(bf16*)(ws + WS_MRG), ws + WS_GATE, nullptr};
            pg8::gemm_phase<pg8::EpiGate<true>, pg8::StaticOrder, true, false>(F.lds + RING_OFF, g, S, E);
            if (!P0_ALLW) conv_queue(F, CW_WQ + 40, 1568, 1664);
            conv_queue(F, CW_WQ + 16, CONV_U1, CONV_U2);
        }
#endif
        if (BOTH(2)) GRID_BAR();
    }

    const bool grp_ok = ONE_LAUNCH && GROUP_BAR && WGM_P3 == WGM_P4 && (F.G & 7) == 0;
    if (IN(3)) {
        if (grp_ok && P34_STAGGER > 0 && ((int)blockIdx.x & 1)) conv_queue(F, CW_WQ + 48, CONV_U2, 1536, P34_STAGGER);
        pg8::StaticOrder S; S.init(TOK, DM, F.G, (int)blockIdx.x, WGM_P3);
        { pg8::Gemm g{OAH + 1024, (const bf16*)(ws + WS_WBA) + 1024, TOK, DM, 1024, DM, DM};
          pg8::EpiGate<false> E{(bf16*)(ws + WS_MRG), ws + WS_GATE, P4_F8 ? ws + WS_MRG8 : nullptr};
          pg8::gemm_phase<pg8::EpiGate<false>, pg8::StaticOrder, true, false>(F.lds + RING_OFF, g, S, E); }
        if (BOTH(3)) { if (grp_ok) group_barrier(F, 0); else GRID_BAR(); }
    }

    if (DBG_REP == 3 && IN(3)) {
        pg8::StaticOrder S; S.init(TOK, DM, F.G, (int)blockIdx.x, WGM_P3);
        { pg8::Gemm g{OAH + 1024, (const bf16*)(ws + WS_WBA) + 1024, TOK, DM, 1024, DM, DM};
          pg8::EpiGate<false> E{(bf16*)(ws + WS_MRG), ws + WS_GATE, P4_F8 ? ws + WS_MRG8 : nullptr};
          pg8::gemm_phase<pg8::EpiGate<false>, pg8::StaticOrder, true, false>(F.lds + RING_OFF, g, S, E); }
        GRID_BAR();
    }

    if (IN(4)) {
        pg8::StaticOrder S; S.init(TOK, DM, F.G, (int)blockIdx.x, WGM_P4);
        pg8::EpiRes E{XN, (const float*)(ws + WS_RS0), (bf16*)(ws + WS_HN), (unsigned char*)F.out + HN8_OFF};
        if (P4_F8) { pg8::Gemm g{(const bf16*)(ws + WS_MRG8), (const bf16*)(ws + WS_WOUT), 0x79797979, 0x7c7c7c7c, DM, DM, DM};
            pg8::gemm_phase_f8<pg8::EpiRes, pg8::StaticOrder, true, false>(F.lds + RING_OFF, g, S, E); }
        else { pg8::Gemm g{(const bf16*)(ws + WS_MRG), (const bf16*)(ws + WS_WOUT), TOK, DM, DM, DM, DM};
            pg8::gemm_phase<pg8::EpiRes, pg8::StaticOrder, false, false, false, (DBG_EPI2 & 4)>(F.lds + RING_OFF, g, S, E); }
        if (BOTH(4)) { if (grp_ok) group_barrier(F, 1); else GRID_BAR(); }
    }

    if (IN(5)) { if (DBG_REP == 5) { p5_router(F, CW_ECNT + 64 * 40, WS_Y); GRID_BAR(); } p5_router(F);
        if (grp_ok && P34_STAGGER > 0 && !((int)blockIdx.x & 1)) conv_queue(F, CW_WQ + 48, CONV_U2, 1536, P34_STAGGER);
        if (BOTH(5)) GRID_BAR(); }

    if (IN(6)) {
        moe_tables(F);
        const LAS int* tile_e = (const LAS int*)(F.lds + X_TILE_E); const LAS int* pstart = (const LAS int*)(F.lds + X_PSTART); const LAS int* ecnt = (const LAS int*)(F.lds + X_ECNT);
        LAS int* tokt = (LAS int*)(F.lds + X_TOKT); LAS float* rst = (LAS float*)(F.lds + X_RST);
        const int ntile = *(const LAS int*)(F.lds + X_NTILE);
        pg8::MoeOrder S{4, ntile * 4, F.G, F.vcu, DM, tile_e, tokt};
        const int* TOKL = (const int*)(ws + WS_TOKL); const float* RSTD = (const float*)(ws + WS_RSTD);
        { int tokv[MAXU];
#pragma unroll
          for (int ui = 0; ui < MAXU; ++ui) { pg8::Unit u; tokv[ui] = 0;
              if (F.tid < 256 && S.next(ui, u)) { const int e = tile_e[u.pm], pos = u.pm * 256 + F.tid - pstart[e]; tokv[ui] = TOKL[e * TOK + (pos < ecnt[e] ? pos : 0)] & (TOK - 1); } }
#pragma unroll
          for (int ui = 0; ui < MAXU; ++ui) if (F.tid < 256) { tokt[ui * 256 + F.tid] = tokv[ui]; rst[ui * 256 + F.tid] = RSTD[tokv[ui]]; } }
        __syncthreads();
        pg8::Gemm g{(const bf16*)((unsigned char*)F.out + HN8_OFF), (const bf16*)(ws + WS_W13), 0x79797979, 0x7f7f7f7f, DM, DM, DM};
        pg8::EpiSwiGLU E{ws + WS_HB, rst};
        pg8::gemm_phase_f8<pg8::EpiSwiGLU, pg8::MoeOrder, true, true, false, (DBG_EPI2 & 8)>(F.lds + RING_OFF, g, S, E);
        conv_queue(F, CW_WQ + 48, CONV_U2, 1536);
        if (BOTH(6)) GRID_BAR();
    }

    if (IN(7)) {
        if (!(ONE_LAUNCH && IN(6))) moe_tables(F);
        const LAS int* tile_e = (const LAS int*)(F.lds + X_TILE_E); const int ntile = *(const LAS int*)(F.lds + X_NTILE);
        pg8::MoeOrder S{8, ntile * 8, F.G, F.vcu, 0, tile_e, nullptr};
        pg8::Gemm g{(const bf16*)(ws + WS_HB), (const bf16*)(ws + WS_W2), 0x7a7a7a7a, 0x7f7f7f7f, DEXP, DEXP, DEXP};
        pg8::EpiY E{ws + WS_Y};
        pg8::gemm_phase_f8<pg8::EpiY, pg8::MoeOrder, true, false, false, (DBG_EPI2 & 16)>(F.lds + RING_OFF, g, S, E);
        if (BOTH(7)) GRID_BAR();
    }

    if (IN(8)) p8_final(F, ONE_LAUNCH && IN(6));
#undef IN
#undef BOTH
#undef GRID_BAR
}
#if defined(DBG_STOP_AFTER)
__global__ void __launch_bounds__(256) dbg_dump(const unsigned char* ws, const bf16* d_scr, float* out, int which) {
    const size_t i = (size_t)blockIdx.x * 256 + threadIdx.x; const size_t t = i >> 11; const int c = (int)(i & 2047);
    auto f = [](bf16 h) { return __uint_as_float((unsigned)h << 16); };
    float v = 0.f;
    if (which == 1) {
        const bf16* QA = (const bf16*)(ws + WS_QA); const bf16* KA = (const bf16*)(ws + WS_KA); const bf16* VA = (const bf16*)(ws + WS_VA); const bf16* QH = (const bf16*)(ws + WS_QH);
        const bf16* LF = (const bf16*)(ws + WS_LF); const bf16* IH = (const bf16*)(ws + WS_IH); const bf16* SOG = (const bf16*)(ws + WS_SOG); const bf16* GATE = (const bf16*)(ws + WS_GATE);
        v = f(QA[t * 1024 + (c & 1023)]) + f(KA[t * 256 + (c & 255)]) + f(VA[t * 256 + (c & 255)]) + f(QH[t * 1024 + (c & 1023)]) + f(LF[t * 1024 + (c & 1023)]) + f(IH[t * 1024 + (c & 1023)]) + f(SOG[t * 1024 + (c & 1023)]) + f(GATE[t * 4096 + c]) + f(GATE[t * 4096 + 2048 + c]);
    } else if (which == 2) { v = f(d_scr[i]); }
    else if (which == 3) { v = f(((const bf16*)(ws + WS_MRG))[i]); }
    else if (which == 0) {
        v = f(d_scr[i]) + f(((const bf16*)(ws + WS_WIN))[i % 19922944]) + f(((const bf16*)(ws + WS_W13))[i]) + f(((const bf16*)(ws + WS_W13))[i + 33554432]) + f(((const bf16*)(ws + WS_W2))[i])
          + f(((const bf16*)(ws + WS_WBA))[i % 2097152]) + f(((const bf16*)(ws + WS_WBH))[i % 2097152]) + f(((const bf16*)(ws + WS_WOUT))[i % 4194304]) + ((const float*)(ws + WS_LB))[i & 1023] + ((const float*)(ws + WS_WR2))[i % 98304];
    }
    out[i] = v;
}
#endif
extern "C" void kernel_launch(void* const* d_in, const int* in_sizes, int n_in, void* d_out, int out_size, void* d_ws, size_t ws_size, hipStream_t stream) {
    static int grid = 0;
    if (grid == 0) {
        if (n_in != 18 || in_sizes[0] != TOK * DM || out_size != TOK * DM || ws_size < WS_END) { fprintf(stderr, "kernel_launch: built for 18 inputs, x and out of %d floats, >= %zu bytes of workspace; got n_in %d, in0 %d, out %d, ws %zu; nothing launched\n", TOK * DM, (size_t)WS_END, n_in, n_in > 0 ? in_sizes[0] : -1, out_size, ws_size); grid = -1; return; }
        int dev = 0, cus = 0, per_cu = 0;
        if (hipGetDevice(&dev) != hipSuccess || hipDeviceGetAttribute(&cus, hipDeviceAttributeMultiprocessorCount, dev) != hipSuccess) { fprintf(stderr, "kernel_launch: hipGetDevice / hipDeviceGetAttribute failed; nothing launched\n"); grid = -1; return; }
        if (hipFuncSetAttribute((const void*)fwd, hipFuncAttributeMaxDynamicSharedMemorySize, LDS_BYTES) != hipSuccess) { fprintf(stderr, "kernel_launch: hipFuncSetAttribute failed\n"); grid = -1; return; }
        if (hipOccupancyMaxActiveBlocksPerMultiprocessor(&per_cu, (const void*)fwd, NWAVES * 64, LDS_BYTES) != hipSuccess || per_cu < 1) { fprintf(stderr, "kernel_launch: occupancy query reports %d workgroups per CU\n", per_cu); }
        (void)hipGetLastError();
        if (cus != 256) { fprintf(stderr, "kernel_launch: built for a 256-CU device (one resident workgroup per CU), found %d CUs; nothing launched\n", cus); grid = -1; return; }
        grid = cus;
    }
    if (grid < 0) return;
    if (hipMemsetAsync((char*)d_ws + WS_CTL, 0, CTL_ZERO_BYTES, stream) != hipSuccess) { fprintf(stderr, "kernel_launch: hipMemsetAsync failed\n"); return; }
    Args a{};
    for (int i = 0; i < 18; ++i) a.in[i] = (const float*)d_in[i];
    a.out = (float*)d_out; a.ws = (unsigned char*)d_ws;
    if (MK_N_LAUNCHES == 1) {
        a.ph_lo = 0; a.ph_hi = N_PHASES;
        hipLaunchKernelGGL(fwd, dim3(grid), dim3(NWAVES * 64), LDS_BYTES, stream, a);
    } else {
        for (int ph = 0; ph < N_PHASES; ++ph) {
#if MK_NAIVE_MIX
            if (ph == 2) {
                unsigned char* ws = (unsigned char*)d_ws; bf16* OA = (bf16*)d_out; bf16* OH = OA + (size_t)TOK * 1024;
                hipLaunchKernelGGL(naive_attn, dim3(TOK * 16 / 256), dim3(256), 0, stream, (const bf16*)(ws + WS_QA), (const bf16*)(ws + WS_KA), (const bf16*)(ws + WS_VA), (const float*)d_in[2], OA);
                hipLaunchKernelGGL(naive_hgrn, dim3(64), dim3(128), 0, stream, (const bf16*)(ws + WS_QH), (const bf16*)(ws + WS_LF), (const bf16*)(ws + WS_IH), (const bf16*)(ws + WS_SOG), (const float*)d_in[4], OH);
                continue;
            }
#endif
#if defined(DBG_NO_MOE)
            if (ph >= 5 && ph <= 7) continue;
#endif
#if defined(DBG_STOP_AFTER)
            if (ph > DBG_STOP_AFTER) {
                unsigned char* ws = (unsigned char*)d_ws;
                if (DBG_STOP_AFTER == 2 || DBG_STOP_AFTER == 0) (void)hipMemcpyAsync(ws + WS_Y, d_out, (size_t)TOK * 2048 * 2, hipMemcpyDeviceToDevice, stream);
                if (DBG_STOP_AFTER != 4) hipLaunchKernelGGL(dbg_dump, dim3(TOK * 2048 / 256), dim3(256), 0, stream, (const unsigned char*)ws, (const bf16*)(ws + WS_Y), (float*)d_out, (int)DBG_STOP_AFTER);
                break;
            }
#endif
            a.ph_lo = ph; a.ph_hi = ph + 1;
            hipLaunchKernelGGL(fwd, dim3(grid), dim3(NWAVES * 64), LDS_BYTES, stream, a);
        }
    }
    hipError_t e = hipGetLastError();
    if (e != hipSuccess) fprintf(stderr, "kernel_launch: launch failed: %s\n", hipGetErrorName(e));
}
```
